# Optimizing an MI355X kernel written in HIP

```python
import math
import jax
import jax.numpy as jnp
from jax import lax
import numpy as np

D_MODEL = 1024
BATCH = 8
SEQ = 4096
DEPTH = 2

N_MIXERS = 2
EPS = 1e-6
NEG_INF = -1e30

MIX_WIDTH = D_MODEL
TOK_WIDTH = 3 * MIX_WIDTH // 4
MEM_WIDTH = MIX_WIDTH // 4

DILATED_GROUPS = ((128, 1), (512, 4), (2048, 16))
ATT_HEAD_DIM = 64
ATT_HEADS = TOK_WIDTH // ATT_HEAD_DIM
HEADS_PER_GROUP = ATT_HEADS // len(DILATED_GROUPS)
BAND_BLOCK = 64
REL_BUCKETS = 32
REL_MAX_DIST = 1024

DN_HEAD_DIM = 128
DN_HEADS = TOK_WIDTH // DN_HEAD_DIM
DN_CONV = 5
DN_CHUNK = 64

MEM_LEN = 256
MEM_HEADS = 4
MEM_HEAD_DIM = MEM_WIDTH // MEM_HEADS

_FF_RAW = -(-8 * D_MODEL // 3)
D_FF = -(-_FF_RAW // 256) * 256

ATT_IN = 3 * TOK_WIDTH + MEM_WIDTH
DN_IN = 4 * TOK_WIDTH + 4 * DN_HEADS + MEM_WIDTH

kernel_name = "hybrid_dilated_attn_gated_deltanet_encoder"


def _rms_norm(x, gain):
    xf = x.astype(jnp.float32)
    y = xf * lax.rsqrt(jnp.mean(xf * xf, axis=-1, keepdims=True) + EPS) * gain.astype(jnp.float32)
    return y.astype(x.dtype)


def _l2norm(t):
    return t * lax.rsqrt(jnp.sum(t * t, axis=-1, keepdims=True) + EPS)


def _t5_bucket(rel):
    half = REL_BUCKETS // 2
    max_exact = half // 2
    n = np.abs(rel)
    large = max_exact + (np.log(np.maximum(n, 1) / max_exact) / math.log(REL_MAX_DIST / max_exact)
                         * (half - max_exact)).astype(np.int64)
    large = np.minimum(large, half - 1)
    return ((rel > 0) * half + np.where(n < max_exact, n, large)).astype(np.int32)


def _dilated_band_attention(q, k, v, bias, dil, half):
    b, s, h, dh = q.shape
    L = s // dil
    nb = -(-L // BAND_BLOCK)
    lp = nb * BAND_BLOCK
    n = b * dil

    def to_sub(t):
        return t.reshape(b, L, dil, h, dh).transpose(0, 2, 1, 3, 4).reshape(n, L, h, dh)

    def key_windows(t):
        t = jnp.pad(to_sub(t), ((0, 0), (BAND_BLOCK, lp - L + BAND_BLOCK), (0, 0), (0, 0)))
        t = t.reshape(n, nb + 2, BAND_BLOCK, h, dh)
        return jnp.concatenate([t[:, :-2], t[:, 1:-1], t[:, 2:]], axis=2)

    qs = jnp.pad(to_sub(q), ((0, 0), (0, lp - L), (0, 0), (0, 0))).reshape(n, nb, BAND_BLOCK, h, dh)
    kw = key_windows(k)
    vw = key_windows(v)

    rel = np.arange(3 * BAND_BLOCK)[None, :] - BAND_BLOCK - np.arange(BAND_BLOCK)[:, None]
    in_band = np.abs(rel) <= half
    kpos = (np.arange(nb)[:, None] - 1) * BAND_BLOCK + np.arange(3 * BAND_BLOCK)[None, :]
    valid = in_band[None] & ((kpos >= 0) & (kpos < L))[:, None, :]
    bias_band = jnp.transpose(bias[np.clip(rel + half, 0, 2 * half)], (2, 0, 1)).astype(jnp.float32)

    logits = jnp.einsum('nbqhd,nbkhd->nbhqk', qs, kw, preferred_element_type=jnp.float32)
    logits = jnp.where(valid[None, :, None], logits + bias_band[None, None], NEG_INF)
    m = jnp.max(logits, axis=-1)
    p = jnp.exp(logits - m[..., None])
    den = jnp.sum(p, axis=-1)
    o = jnp.einsum('nbhqk,nbkhd->nbqhd', p.astype(v.dtype), vw, preferred_element_type=jnp.float32)
    o = o / jnp.swapaxes(den, -1, -2)[..., None]

    def from_sub(t):
        rest = t.shape[3:]
        t = t.reshape((b, dil, lp) + rest)[:, :, :L]
        return jnp.swapaxes(t, 1, 2).reshape((b, s) + rest)

    return from_sub(o), from_sub(jnp.swapaxes(m, -1, -2)), from_sub(jnp.swapaxes(den, -1, -2))


def _dilated_mixture(q, k, v, rel_bias):
    b, s = q.shape[:2]
    outs, lses = [], []
    for gi, (window, dil) in enumerate(DILATED_GROUPS):
        half = window // (2 * dil)
        heads = slice(gi * HEADS_PER_GROUP, (gi + 1) * HEADS_PER_GROUP)
        bias = rel_bias[_t5_bucket(np.arange(-half, half + 1) * dil)][:, heads]
        o, m, den = _dilated_band_attention(q[:, :, heads], k[:, :, heads], v[:, :, heads], bias, dil, half)
        outs.append(o)
        lses.append(m + jnp.log(den))
    wts = jax.nn.softmax(jnp.stack(lses), axis=0)
    mixed = jnp.concatenate([o * w[..., None] for o, w in zip(outs, wts)], axis=2)
    return mixed.reshape(b, s, TOK_WIDTH)


def _memory_attention(q_mem, mem_n, w_kv):
    b, s, _ = q_mem.shape
    q = q_mem.reshape(b, s, MEM_HEADS, MEM_HEAD_DIM) * (MEM_HEAD_DIM ** -0.5)
    k, v = jnp.split(mem_n @ w_kv, 2, axis=-1)
    k = k.reshape(b, -1, MEM_HEADS, MEM_HEAD_DIM)
    v = v.reshape(b, -1, MEM_HEADS, MEM_HEAD_DIM)
    logits = jnp.einsum('bshd,bmhd->bhsm', q, k, preferred_element_type=jnp.float32)
    p = jax.nn.softmax(logits, axis=-1)
    o = jnp.einsum('bhsm,bmhd->bshd', p.astype(v.dtype), v)
    return o.reshape(b, s, MEM_WIDTH)


def _gated_delta_chunked(q, k, v, g, beta):
    b, s, h, dk = q.shape
    dv = v.shape[-1]
    nc = s // DN_CHUNK

    def chunks(t):
        t = t.reshape((b, nc, DN_CHUNK, h) + t.shape[3:])
        return jnp.moveaxis(t, 3, 1)

    q, k, v, g, beta = (chunks(t) for t in (q, k, v, g, beta))
    g = jnp.cumsum(g, axis=-1)
    tril = np.tril(np.ones((DN_CHUNK, DN_CHUNK), dtype=bool))
    strict = np.tril(np.ones((DN_CHUNK, DN_CHUNK), dtype=bool), -1)
    decay = jnp.exp(jnp.where(tril, g[..., :, None] - g[..., None, :], NEG_INF))
    k_beta = k * beta[..., None]
    lmat = jnp.where(strict, jnp.einsum('bhnik,bhnjk->bhnij', k_beta, k) * decay, 0.0)
    a = lmat + jnp.eye(DN_CHUNK, dtype=jnp.float32)
    rhs = jnp.concatenate([v * beta[..., None], k_beta * jnp.exp(g)[..., None]], axis=-1)
    sol = lax.linalg.triangular_solve(a, rhs, left_side=True, lower=True, unit_diagonal=True)
    u, w = sol[..., :dv], sol[..., dv:]
    intra = jnp.where(tril, jnp.einsum('bhnik,bhnjk->bhnij', q, k) * decay, 0.0)

    def step(state, inp):
        qc, kc, uc, wc, gc, ac = inp
        v_new = uc - jnp.einsum('bhck,bhkv->bhcv', wc, state)
        out = (jnp.einsum('bhck,bhkv->bhcv', qc * jnp.exp(gc)[..., None], state)
               + jnp.einsum('bhij,bhjv->bhiv', ac, v_new))
        g_last = gc[..., -1]
        state = (state * jnp.exp(g_last)[..., None, None]
                 + jnp.einsum('bhck,bhcv->bhkv', kc * jnp.exp(g_last[..., None] - gc)[..., None], v_new))
        return state, out

    xs = tuple(jnp.moveaxis(t, 2, 0) for t in (q, k, u, w, g, intra))
    state0 = jnp.zeros((b, h, dk, dv), jnp.float32)
    _, out = lax.scan(step, state0, xs)
    out = jnp.moveaxis(out, 0, 2)
    return jnp.moveaxis(out, 1, 3).reshape(b, s, h, dv)


def _attention_sublayer(h, mem_n, w_in, w_out, rel_bias, w_mem_kv):
    b, s, _ = h.shape
    q, k, v, q_mem = jnp.split(h @ w_in, [TOK_WIDTH, 2 * TOK_WIDTH, 3 * TOK_WIDTH], axis=-1)
    q = q.reshape(b, s, ATT_HEADS, ATT_HEAD_DIM) * (ATT_HEAD_DIM ** -0.5)
    k = k.reshape(b, s, ATT_HEADS, ATT_HEAD_DIM)
    v = v.reshape(b, s, ATT_HEADS, ATT_HEAD_DIM)
    mixed = _dilated_mixture(q, k, v, rel_bias).astype(h.dtype)
    mem_out = _memory_attention(q_mem, mem_n, w_mem_kv)
    return jnp.concatenate([mixed, mem_out], axis=-1) @ w_out


def _deltanet_sublayer(h, mem_n, w_in, conv_w, a_log, dt_bias, out_norm, w_out, w_mem_kv):
    b, s, _ = h.shape
    qkv, z, gate_in, q_mem = jnp.split(
        h @ w_in, [3 * TOK_WIDTH, 4 * TOK_WIDTH, 4 * TOK_WIDTH + 4 * DN_HEADS], axis=-1)
    qkv = lax.conv_general_dilated(
        qkv, conv_w[:, None, :], window_strides=(1,), padding=[(DN_CONV // 2, DN_CONV // 2)],
        dimension_numbers=('NWC', 'WIO', 'NWC'), feature_group_count=3 * TOK_WIDTH)
    q, k, v = jnp.split(jax.nn.silu(qkv).astype(jnp.float32), 3, axis=-1)
    q = _l2norm(q.reshape(b, s, DN_HEADS, DN_HEAD_DIM)) * (DN_HEAD_DIM ** -0.5)
    k = _l2norm(k.reshape(b, s, DN_HEADS, DN_HEAD_DIM))
    v = v.reshape(b, s, DN_HEADS, DN_HEAD_DIM)
    gate_in = gate_in.astype(jnp.float32).reshape(b, s, 2, 2, DN_HEADS)
    g = -jnp.exp(a_log.astype(jnp.float32)) * jax.nn.softplus(gate_in[:, :, :, 0] + dt_bias.astype(jnp.float32))
    beta = jax.nn.sigmoid(gate_in[:, :, :, 1])
    o_fwd = _gated_delta_chunked(q, k, v, g[:, :, 0], beta[:, :, 0])
    rev = lambda t: jnp.flip(t, axis=1)
    o_bwd = rev(_gated_delta_chunked(rev(q), rev(k), rev(v), rev(g[:, :, 1]), rev(beta[:, :, 1])))
    o = o_fwd + o_bwd
    zf = z.astype(jnp.float32).reshape(b, s, DN_HEADS, DN_HEAD_DIM)
    o = (o * lax.rsqrt(jnp.mean(o * o, axis=-1, keepdims=True) + EPS)
         * out_norm.astype(jnp.float32) * jax.nn.silu(zf))
    o = o.reshape(b, s, TOK_WIDTH).astype(h.dtype)
    mem_out = _memory_attention(q_mem, mem_n, w_mem_kv)
    return jnp.concatenate([o, mem_out], axis=-1) @ w_out


def _swiglu(h, w_gate_up, w_down):
    gate, up = jnp.split(h @ w_gate_up, 2, axis=-1)
    return (jax.nn.silu(gate) * up) @ w_down


def setup_inputs(seed: int = 0) -> dict:
    key = jax.random.key(seed)
    ks = jax.random.split(key, 24)
    n_att = (DEPTH + N_MIXERS - 1) // N_MIXERS
    n_dn = DEPTH // N_MIXERS

    def nrm(k, shape, scale):
        return jax.random.normal(k, shape, jnp.float32) * scale

    def gain(k, shape):
        return 1.0 + nrm(k, shape, 0.05)

    dt = jnp.exp(jax.random.uniform(ks[8], (n_dn, 2, DN_HEADS), jnp.float32,
                                    minval=math.log(1e-3), maxval=math.log(1e-1)))
    return {
        "x": nrm(ks[0], (BATCH, SEQ, D_MODEL), 1.0),
        "mem": nrm(ks[1], (BATCH, MEM_LEN, D_MODEL), 1.0),
        "rel_bias": nrm(ks[2], (REL_BUCKETS, ATT_HEADS), 0.5),
        "att_w_in": nrm(ks[3], (n_att, D_MODEL, ATT_IN), D_MODEL ** -0.5),
        "att_w_out": nrm(ks[4], (n_att, MIX_WIDTH, D_MODEL), MIX_WIDTH ** -0.5),
        "dn_w_in": nrm(ks[5], (n_dn, D_MODEL, DN_IN), D_MODEL ** -0.5),
        "dn_conv": nrm(ks[6], (n_dn, DN_CONV, 3 * TOK_WIDTH), DN_CONV ** -0.5),
        "dn_a_log": jnp.log(jax.random.uniform(ks[7], (n_dn, 2, DN_HEADS), jnp.float32, minval=1.0, maxval=16.0)),
        "dn_dt_bias": dt + jnp.log(-jnp.expm1(-dt)),
        "dn_out_norm": gain(ks[9], (n_dn, DN_HEAD_DIM)),
        "dn_w_out": nrm(ks[10], (n_dn, MIX_WIDTH, D_MODEL), MIX_WIDTH ** -0.5),
        "mem_norm": gain(ks[11], (DEPTH, D_MODEL)),
        "mem_w_kv": nrm(ks[12], (DEPTH, D_MODEL, 2 * MEM_WIDTH), D_MODEL ** -0.5),
        "norm_mix_pre": gain(ks[13], (DEPTH, D_MODEL)),
        "norm_mix_post": gain(ks[14], (DEPTH, D_MODEL)),
        "norm_ffn_pre": gain(ks[15], (DEPTH, D_MODEL)),
        "norm_ffn_post": gain(ks[16], (DEPTH, D_MODEL)),
        "ffn_w_gate_up": nrm(ks[17], (DEPTH, D_MODEL, 2 * D_FF), D_MODEL ** -0.5),
        "ffn_w_down": nrm(ks[18], (DEPTH, D_FF, D_MODEL), D_FF ** -0.5),
    }


def reference(x, mem, rel_bias, att_w_in, att_w_out, dn_w_in, dn_conv, dn_a_log, dn_dt_bias,
              dn_out_norm, dn_w_out, mem_norm, mem_w_kv, norm_mix_pre, norm_mix_post,
              norm_ffn_pre, norm_ffn_post, ffn_w_gate_up, ffn_w_down):
    for i in range(DEPTH):
        j = i // N_MIXERS
        h = _rms_norm(x, norm_mix_pre[i])
        mem_n = _rms_norm(mem, mem_norm[i])
        if i % N_MIXERS == 0:
            mixed = _attention_sublayer(h, mem_n, att_w_in[j], att_w_out[j], rel_bias, mem_w_kv[i])
        else:
            mixed = _deltanet_sublayer(h, mem_n, dn_w_in[j], dn_conv[j], dn_a_log[j], dn_dt_bias[j],
                                       dn_out_norm[j], dn_w_out[j], mem_w_kv[i])
        x = x + _rms_norm(mixed, norm_mix_post[i])
        h = _rms_norm(x, norm_ffn_pre[i])
        x = x + _rms_norm(_swiglu(h, ffn_w_gate_up[i], ffn_w_down[i]), norm_ffn_post[i])
    return x
```

```cpp
#include <hip/hip_runtime.h>
#include <cstdio>
#include <cstdint>
#define MK_N_LAUNCHES 1
namespace pg8 {
#define PG8_LAS __attribute__((address_space(3)))
typedef unsigned short bf16_t;
typedef short bf16x8 __attribute__((ext_vector_type(8)));
typedef float f32x4 __attribute__((ext_vector_type(4)));
typedef unsigned u32x4 __attribute__((ext_vector_type(4)));
constexpr int BM = 256, BK = 64, HALF = 128, HTB = HALF * BK * 2  , STAGE_BYTES = 8 * HTB, NXCD = 8, WGM = 8;

__host__ __device__ __forceinline__ int lds_byte(int r, int c) { const int st = (r >> 4) * 2 + (c >> 5), rr = r & 15, cc = c & 31, ob = rr * 64 + cc * 2; return st * 1024 + (ob ^ (((ob >> 9) & 1) << 5)); }
__host__ __device__ __forceinline__ void stage_rc(int b, int& R, int& C) { const int st = b / 1024, sb = b % 1024, swz = sb ^ (((sb >> 9) & 1) << 5); R = (st >> 1) * 16 + swz / 64; C = (st & 1) * 32 + (swz % 64) / 2; }
__host__ __device__ __forceinline__ int perm32(int rho) { const int n = rho >> 4, i = rho & 15; return 8 * (i >> 2) + 4 * n + (i & 3); }

struct Unit { int pm, pn; };
struct Gemm { const bf16_t* A; const bf16_t* Bt; int M, N, K; };

struct StaticOrder {
    int nM, nN, nwg, G, c;
    __host__ __device__ void init(int M, int N, int G_, int c_) { nM = M / BM; nN = N / BM; nwg = nM * nN; G = G_; c = c_; }
    __host__ __device__ bool next(int i, Unit& u) const {
        const long L = (long)i * G + c; if (L >= nwg) return false;
        int wgid = (int)L; { const int q = nwg / NXCD, r = nwg % NXCD, xcd = wgid % NXCD, off = wgid / NXCD; wgid = (xcd < r ? xcd * (q + 1) : r * (q + 1) + (xcd - r) * q) + off; }
        const int nig = WGM * nN, gid = wgid / nig, fm = gid * WGM, gsz = (nM - fm) < WGM ? (nM - fm) : WGM;
        u.pm = fm + ((wgid % nig) % gsz); u.pn = (wgid % nig) / gsz; return true;
    }
    __device__ __forceinline__ void a_ready(const Unit&) const {}
    __device__ __forceinline__ void done(const Unit&) const {}
};

__device__ __forceinline__ unsigned cvt_pk_bf16(float lo, float hi) { unsigned r; asm volatile("v_cvt_pk_bf16_f32 %0, %1, %2" : "=v"(r) : "v"(lo), "v"(hi)); return r; }
typedef float f32x2 __attribute__((ext_vector_type(2)));
struct EpiF32 {
    static constexpr bool PERM = false, AFTER_DRAIN = false;
    float* C; int ldc;
    __device__ __forceinline__ void operator()(const f32x4 (&acc)[2][2][4][2], const Unit& u, int wr, int wc, int fr, int fq) const {
        const int row0 = u.pm * BM + wr * 64 + fr, col0 = u.pn * BM + wc * 32 + 4 * fq;
#pragma unroll
        for (int ai = 0; ai < 2; ++ai)
#pragma unroll
            for (int m = 0; m < 4; ++m) { float* rowp = C + (size_t)(row0 + ai * HALF + m * 16) * ldc + col0;
#pragma unroll
                for (int bj = 0; bj < 2; ++bj)
#pragma unroll
                    for (int n = 0; n < 2; ++n) *(f32x4*)(rowp + bj * HALF + n * 16) = acc[ai][bj][m][n]; }
    }
};
struct EpiRoute {
    static constexpr bool PERM = true, AFTER_DRAIN = false;
    int mode; bf16_t* O; int ldc; bf16_t* O2; int ldc2; float* gate;
    __device__ __forceinline__ void operator()(const f32x4 (&acc)[2][2][4][2], const Unit& u, int wr, int wc, int fr, int fq) const {
        const int row0 = u.pm * BM + wr * 64 + fr;
        if (mode == 1 && u.pn == 13) {
            if (wc == 0 && fq < 3) {
#pragma unroll
                for (int ai = 0; ai < 2; ++ai)
#pragma unroll
                    for (int m = 0; m < 4; ++m) { float* rowp = gate + (size_t)(row0 + ai * HALF + m * 16) * 24 + 8 * fq;
                        *(f32x4*)(rowp) = acc[ai][0][m][0]; *(f32x4*)(rowp + 4) = acc[ai][0][m][1]; }
            }
            return;
        }
        bf16_t* base = O; int ld = ldc; int colt = u.pn * BM;
        if (mode == 1 && u.pn >= 9) { base = O2; ld = ldc2; colt = (u.pn - 9) * BM; }
        const int col0 = colt + wc * 32 + 8 * fq;
#pragma unroll
        for (int ai = 0; ai < 2; ++ai)
#pragma unroll
            for (int m = 0; m < 4; ++m) { bf16_t* rowp = base + (size_t)(row0 + ai * HALF + m * 16) * ld + col0;
#pragma unroll
                for (int bj = 0; bj < 2; ++bj) { const f32x4 v0 = acc[ai][bj][m][0], v1 = acc[ai][bj][m][1];
                    u32x4 w; w.x = cvt_pk_bf16(v0[0], v0[1]); w.y = cvt_pk_bf16(v0[2], v0[3]); w.z = cvt_pk_bf16(v1[0], v1[1]); w.w = cvt_pk_bf16(v1[2], v1[3]);
                    *(u32x4*)(rowp + bj * HALF) = w; } }
    }
};
__device__ __forceinline__ float silu_f(float x) { return x * __builtin_amdgcn_rcpf(1.0f + __expf(-x)); }
struct EpiSwiglu {
    static constexpr bool PERM = true, AFTER_DRAIN = false;
    bf16_t* H; int ldh;
    __device__ __forceinline__ void operator()(const f32x4 (&acc)[2][2][4][2], const Unit& u, int wr, int wc, int fr, int fq) const {
        const int row0 = u.pm * BM + wr * 64 + fr, col0 = u.pn * HALF + wc * 32 + 8 * fq;
#pragma unroll
        for (int ai = 0; ai < 2; ++ai)
#pragma unroll
            for (int m = 0; m < 4; ++m) { bf16_t* rowp = H + (size_t)(row0 + ai * HALF + m * 16) * ldh + col0;
                const f32x4 g0 = acc[ai][0][m][0], g1 = acc[ai][0][m][1], u0 = acc[ai][1][m][0], u1 = acc[ai][1][m][1];
                u32x4 w; w.x = cvt_pk_bf16(silu_f(g0[0]) * u0[0], silu_f(g0[1]) * u0[1]); w.y = cvt_pk_bf16(silu_f(g0[2]) * u0[2], silu_f(g0[3]) * u0[3]);
                w.z = cvt_pk_bf16(silu_f(g1[0]) * u1[0], silu_f(g1[1]) * u1[1]); w.w = cvt_pk_bf16(silu_f(g1[2]) * u1[2], silu_f(g1[3]) * u1[3]);
                *(u32x4*)(rowp) = w; }
    }
};

template <class Epi, class Sched, bool ALIGN_EPI = false, bool SP2 = false>
__device__ __forceinline__ void gemm_phase(PG8_LAS unsigned char* lds, const Gemm g, const Sched& S, const Epi& E) {
    const int tid = threadIdx.x, wid = __builtin_amdgcn_readfirstlane(tid >> 6), lane = tid & 63, wr = wid >> 2, wc = wid & 3, fr = lane & 15, fq = lane >> 4;
    const int K = g.K, nt = K / BK;
    unsigned voffA[2], voffB[2];
#pragma unroll
    for (int i = 0; i < 2; ++i) { int R, C; stage_rc(tid * 16 + i * 8192, R, C); const int Rb = Epi::PERM ? ((R & ~31) + perm32(R & 31)) : R;
        voffA[i] = (unsigned)(R * K + C) * 2u; voffB[i] = (unsigned)(Rb * K + C) * 2u; }
    const size_t kstep = (size_t)(BK * 2);
    const size_t hstep = (size_t)HALF * K * 2;
    const size_t tstep = 2 * hstep;
    const unsigned ldsw = (unsigned)wid * 1024u;
    const int aoff = lds_byte(wr * 64 + fr, fq * 8), boff = lds_byte(wc * 32 + fr, fq * 8);
#define PG8_SA(b, h) (((b) * 2 + (h)) * HTB)
#define PG8_SB(b, h) ((4 + (b) * 2 + (h)) * HTB)
#define PG8_STAGE(bufoff, gbase, voff) do { _Pragma("unroll") for (int _i = 0; _i < 2; ++_i) \
        __builtin_amdgcn_global_load_lds((const unsigned*)((const char*)(gbase) + (voff)[_i]), (PG8_LAS unsigned*)(lds + (bufoff) + ldsw + _i * 8192), 16, 0, 0); } while (0)
#define PG8_LDA(dst, b, h) do { _Pragma("unroll") for (int m = 0; m < 4; ++m) _Pragma("unroll") for (int k = 0; k < 2; ++k) dst[m][k] = *(const PG8_LAS bf16x8*)(lds + PG8_SA(b, h) + aoff + m * 2048 + k * 1024); } while (0)
#define PG8_LDB(dst, b, h) do { _Pragma("unroll") for (int n = 0; n < 2; ++n) _Pragma("unroll") for (int k = 0; k < 2; ++k) dst[n][k] = *(const PG8_LAS bf16x8*)(lds + PG8_SB(b, h) + boff + n * 2048 + k * 1024); } while (0)
#define PG8_MMA(ai, bj, At, Bt) do { __builtin_amdgcn_s_setprio(1); _Pragma("unroll") for (int m = 0; m < 4; ++m) _Pragma("unroll") for (int n = 0; n < 2; ++n) _Pragma("unroll") for (int k = 0; k < 2; ++k) \
        acc[ai][bj][m][n] = __builtin_amdgcn_mfma_f32_16x16x32_bf16(Bt[n][k], At[m][k], acc[ai][bj][m][n], 0, 0, 0); __builtin_amdgcn_s_setprio(0); } while (0)
#define PG8_WAIT_V(n) asm volatile("s_waitcnt vmcnt(" #n ")" ::: "memory")
#define PG8_WAIT_L(n) asm volatile("s_waitcnt lgkmcnt(" #n ")" ::: "memory")
#define PG8_BAR __builtin_amdgcn_s_barrier()
#define PG8_SCHED __builtin_amdgcn_sched_barrier(0)
    Unit cur, nxt; int ui = 0;
    if (!S.next(0, cur)) return;
    f32x4 acc[2][2][4][2];
#pragma unroll
    for (int a = 0; a < 2; ++a)
#pragma unroll
        for (int b = 0; b < 2; ++b)
#pragma unroll
            for (int m = 0; m < 4; ++m)
#pragma unroll
                for (int n = 0; n < 2; ++n) acc[a][b][m][n] = (f32x4){0.f, 0.f, 0.f, 0.f};
    bf16x8 At[4][2], B0[2][2], B1[2][2];
    const char* cA = (const char*)g.A + (size_t)cur.pm * tstep; const char* cB = (const char*)g.Bt + (size_t)cur.pn * tstep;
    S.a_ready(cur);
    if constexpr (SP2) {
        PG8_STAGE(PG8_SB(0, 0), cB, voffB); PG8_STAGE(PG8_SB(0, 1), cB + hstep, voffB); PG8_STAGE(PG8_SA(0, 0), cA, voffA); PG8_STAGE(PG8_SA(0, 1), cA + hstep, voffA);
        if (wr == 1) PG8_BAR;
        PG8_WAIT_V(2); PG8_BAR;
        PG8_STAGE(PG8_SB(1, 0), cB + kstep, voffB); PG8_STAGE(PG8_SA(1, 0), cA + kstep, voffA); PG8_STAGE(PG8_SB(1, 1), cB + hstep + kstep, voffB);
        PG8_WAIT_V(6); PG8_BAR;
    } else {
        PG8_STAGE(PG8_SB(0, 0), cB, voffB); PG8_STAGE(PG8_SA(0, 0), cA, voffA); PG8_STAGE(PG8_SB(0, 1), cB + hstep, voffB); PG8_STAGE(PG8_SA(0, 1), cA + hstep, voffA);
        if (wr == 1) PG8_BAR;
        PG8_WAIT_V(4); PG8_BAR;
        PG8_STAGE(PG8_SB(1, 0), cB + kstep, voffB); PG8_STAGE(PG8_SA(1, 0), cA + kstep, voffA); PG8_STAGE(PG8_SB(1, 1), cB + hstep + kstep, voffB);
        PG8_WAIT_V(6); PG8_BAR;
    }
    for (;;) {
        const bool has_next = S.next(ui + 1, nxt);
        const char* nA = has_next ? (const char*)g.A + (size_t)nxt.pm * tstep : cA; const char* nB = has_next ? (const char*)g.Bt + (size_t)nxt.pn * tstep : cB;
        for (int t = 0; t < nt; t += 2) {
            const bool last = (t == nt - 2);
            const char* a1 = cA + (size_t)(t + 1) * kstep;
            const char* a2 = last ? nA : cA + (size_t)(t + 2) * kstep; const char* b2 = last ? nB : cB + (size_t)(t + 2) * kstep;
            const char* a3 = a2 + kstep; const char* b3 = b2 + kstep;
            if (last && has_next) S.a_ready(nxt);
            if constexpr (SP2) {
            PG8_LDB(B0, 0, 0); PG8_LDB(B1, 0, 1); PG8_SCHED; PG8_LDA(At, 0, 0); PG8_STAGE(PG8_SA(1, 1), a1 + hstep, voffA);
            PG8_WAIT_V(8); PG8_WAIT_L(0); PG8_BAR; PG8_MMA(0, 0, At, B0); PG8_MMA(0, 1, At, B1); PG8_BAR; PG8_SCHED;
            PG8_LDA(At, 0, 1); PG8_STAGE(PG8_SB(0, 0), b2, voffB); PG8_STAGE(PG8_SB(0, 1), b2 + hstep, voffB); PG8_STAGE(PG8_SA(0, 0), a2, voffA);
            PG8_WAIT_V(8); PG8_WAIT_L(0); PG8_BAR; PG8_MMA(1, 0, At, B0); PG8_MMA(1, 1, At, B1); PG8_BAR; PG8_SCHED;
            PG8_LDB(B0, 1, 0); PG8_LDB(B1, 1, 1); PG8_SCHED; PG8_LDA(At, 1, 0); PG8_STAGE(PG8_SA(0, 1), a2 + hstep, voffA);
            PG8_WAIT_V(8); PG8_WAIT_L(0); PG8_BAR; PG8_MMA(0, 0, At, B0); PG8_MMA(0, 1, At, B1); PG8_BAR; PG8_SCHED;
            PG8_LDA(At, 1, 1); PG8_STAGE(PG8_SB(1, 0), b3, voffB); PG8_STAGE(PG8_SB(1, 1), b3 + hstep, voffB); PG8_STAGE(PG8_SA(1, 0), a3, voffA);
            PG8_WAIT_V(8); PG8_WAIT_L(0); PG8_BAR; PG8_MMA(1, 0, At, B0); PG8_MMA(1, 1, At, B1); PG8_BAR; PG8_SCHED;
            } else {
            PG8_LDB(B0, 0, 0); PG8_SCHED; PG8_LDA(At, 0, 0); PG8_STAGE(PG8_SA(1, 1), a1 + hstep, voffA);
            PG8_WAIT_L(8); PG8_BAR; PG8_WAIT_L(0); PG8_MMA(0, 0, At, B0); PG8_BAR; PG8_SCHED;
            PG8_LDB(B1, 0, 1); PG8_STAGE(PG8_SB(0, 0), b2, voffB);
            PG8_BAR; PG8_WAIT_L(0); PG8_MMA(0, 1, At, B1); PG8_BAR;
            PG8_LDA(At, 0, 1); PG8_STAGE(PG8_SA(0, 0), a2, voffA);
            PG8_BAR; PG8_WAIT_L(0); PG8_MMA(1, 0, At, B0); PG8_BAR; PG8_SCHED;
            PG8_STAGE(PG8_SB(0, 1), b2 + hstep, voffB);
            PG8_WAIT_V(6); PG8_BAR; PG8_MMA(1, 1, At, B1); PG8_BAR;
            PG8_LDB(B0, 1, 0); PG8_SCHED; PG8_LDA(At, 1, 0); PG8_STAGE(PG8_SA(0, 1), a2 + hstep, voffA);
            PG8_WAIT_L(8); PG8_BAR; PG8_WAIT_L(0); PG8_MMA(0, 0, At, B0); PG8_BAR; PG8_SCHED;
            PG8_LDB(B1, 1, 1); PG8_STAGE(PG8_SB(1, 0), b3, voffB);
            PG8_BAR; PG8_WAIT_L(0); PG8_MMA(0, 1, At, B1); PG8_BAR;
            PG8_LDA(At, 1, 1); PG8_STAGE(PG8_SA(1, 0), a3, voffA);
            PG8_BAR; PG8_WAIT_L(0); PG8_MMA(1, 0, At, B0); PG8_BAR; PG8_SCHED;
            PG8_STAGE(PG8_SB(1, 1), b3 + hstep, voffB);
            PG8_WAIT_V(6); PG8_BAR; PG8_MMA(1, 1, At, B1); PG8_BAR;
            }
        }
        if constexpr (ALIGN_EPI) { if (wr == 0) PG8_BAR; }
        if constexpr (!Epi::AFTER_DRAIN) { E(acc, cur, wr, wc, fr, fq); S.done(cur); }
        if (!has_next) break;
#pragma unroll
        for (int a = 0; a < 2; ++a)
#pragma unroll
            for (int b = 0; b < 2; ++b)
#pragma unroll
                for (int m = 0; m < 4; ++m)
#pragma unroll
                    for (int n = 0; n < 2; ++n) acc[a][b][m][n] = (f32x4){0.f, 0.f, 0.f, 0.f};
        cur = nxt; cA = nA; cB = nB; ++ui;
        if constexpr (ALIGN_EPI) { if (wr == 1) PG8_BAR; }
    }
    PG8_WAIT_V(0);
    if constexpr (!ALIGN_EPI) { if (wr == 0) PG8_BAR; }
    PG8_BAR;
    if constexpr (Epi::AFTER_DRAIN) { E.fused(acc, cur, wr, wc, fr, fq, lds, wid, lane); S.done(cur); }
#undef PG8_SA
#undef PG8_SB
#undef PG8_STAGE
#undef PG8_LDA
#undef PG8_LDB
#undef PG8_MMA
#undef PG8_WAIT_V
#undef PG8_WAIT_L
#undef PG8_BAR
#undef PG8_SCHED
}
}
constexpr int NWAVES = 8;
#ifndef MK_N_LAUNCHES
#define MK_N_LAUNCHES 1
#endif
constexpr int N_PHASES = 17;
constexpr int N_LAUNCHES = MK_N_LAUNCHES;
#ifndef PG8_SP2
#define PG8_SP2 true
#endif
#ifndef PG8_ALIGN
#define PG8_ALIGN true
#endif

constexpr int NB = 8, SEQ = 4096, D = 1024, T = NB * SEQ;
constexpr int TOKW = 768, MEMW = 256, MEML = 256;
constexpr int ATT_IN = 2560, DN_IN = 3352, DN_IN_P = 3584, DFF = 2816, GU = 2 * DFF;
constexpr int NHEAD_A = 12, NHEAD_D = 6, DNH = 128, NCHUNK = 64, CH = 64;
constexpr float EPS = 1e-6f;

constexpr size_t MiB = 1u << 20;
constexpr size_t WS_CTL = 0, CTL_ZERO_BYTES = 64 * 1024;
constexpr size_t WS_W_ATT_IN = 2 * MiB;
constexpr size_t WS_W_ATT_OUT = 7 * MiB;
constexpr size_t WS_W_DN_IN = 9 * MiB;
constexpr size_t WS_W_DN_OUT = 16 * MiB;
constexpr size_t WS_W_MEMKV = 18 * MiB;
constexpr size_t WS_W_GU = 20 * MiB;
constexpr size_t WS_W_DOWN = 42 * MiB;
constexpr size_t WS_MEMN = 54 * MiB;
constexpr size_t WS_MEMKV = 62 * MiB;
constexpr size_t WS_LSE = 66 * MiB;
constexpr size_t WS_GATE = 68 * MiB;
constexpr size_t WS_XN = 80 * MiB;
constexpr size_t WS_MIX = 144 * MiB;
constexpr size_t WS_Y = 208 * MiB;
constexpr size_t WS_BIG = 336 * MiB;
constexpr size_t WS_END = 512 * MiB;
constexpr int CW_BAR = 4096;

constexpr int RING_OFF = 0, RING_BYTES = 131072;
constexpr int LDSCTL_OFF = RING_BYTES, MISC_OFF = LDSCTL_OFF + 320;
constexpr int LDS_BYTES = 147456;

#define GAS __attribute__((address_space(1)))
#define LAS __attribute__((address_space(3)))
typedef unsigned short bf16;
typedef unsigned v4u __attribute__((ext_vector_type(4)));
typedef unsigned v2u __attribute__((ext_vector_type(2)));
typedef float f32x4 __attribute__((ext_vector_type(4)));
typedef GAS unsigned gu32;
#define RLX_AGENT __ATOMIC_RELAXED, __HIP_MEMORY_SCOPE_AGENT
#define LDS_WAIT() asm volatile("s_waitcnt lgkmcnt(0)" ::: "memory")
__device__ __forceinline__ unsigned f2bf(float f) { unsigned u = __builtin_bit_cast(unsigned, f); return (u + 0x7fffu + ((u >> 16) & 1u)) >> 16; }
__device__ __forceinline__ unsigned pk2(float lo, float hi) { return f2bf(lo) | (f2bf(hi) << 16); }
__device__ __forceinline__ float bf2f(unsigned b) { return __builtin_bit_cast(float, b << 16); }
__device__ __forceinline__ float bflo(unsigned w) { return __builtin_bit_cast(float, w << 16); }
__device__ __forceinline__ float bfhi(unsigned w) { return __builtin_bit_cast(float, w & 0xffff0000u); }
__device__ __forceinline__ float wave_sum(float v) {
#pragma unroll
    for (int o = 1; o < 64; o <<= 1) v += __shfl_xor(v, o);
    return v;
}
__device__ __forceinline__ float wave_max(float v) {
#pragma unroll
    for (int o = 1; o < 64; o <<= 1) v = fmaxf(v, __shfl_xor(v, o));
    return v;
}
__device__ __forceinline__ float silu(float x) { return x / (1.0f + __expf(-x)); }

#define XB_TMO      128
#define XB_XCNT(j)  (256  + 64 * (j))
#define XB_XSUB(j)  (1280 + 64 * (j))
#define XB_XGEN(j)  (2304 + 64 * (j))
#define XB_TOP      3328
#define XB_TOPGEN   3392
#define XCD_BAR_WORDS 3456
#define XB_SPIN_CAP (1u << 18)

__device__ __forceinline__ unsigned xb_ld(unsigned* p)              { return __hip_atomic_load(p, __ATOMIC_RELAXED, __HIP_MEMORY_SCOPE_AGENT); }
__device__ __forceinline__ unsigned xb_add(unsigned* p, unsigned v) { return __hip_atomic_fetch_add(p, v, __ATOMIC_RELAXED, __HIP_MEMORY_SCOPE_AGENT); }
__device__ __forceinline__ unsigned xb_xcc_id() { return (unsigned)__builtin_amdgcn_s_getreg((3 << 11) | 20) & 0xFu; }
#define XB_SPIN(cond, bar) do { unsigned _sp = 0; while (cond) { __builtin_amdgcn_s_sleep(1); \
    if ((++_sp & 255u) == 0u) { if (xb_ld(&(bar)[XB_TMO])) break; if (_sp > XB_SPIN_CAP) { atomicAdd(&(bar)[XB_TMO], 1u); break; } } } } while (0)

struct XcdBarrier {
    unsigned* bar; unsigned x;
    volatile LAS unsigned* st;
};

__device__ __forceinline__ XcdBarrier xcd_barrier_post(unsigned* bar, volatile LAS unsigned* st) {
    XcdBarrier b; b.bar = bar; b.x = xb_xcc_id(); b.st = st;
    if (threadIdx.x == 0) (void)xb_add(&bar[XB_XCNT(b.x)], 1u);
    return b;
}
__device__ __forceinline__ void xcd_barrier_complete(unsigned* bar, unsigned x, unsigned& nloc, unsigned& nx) {
    const unsigned G = gridDim.x * gridDim.y * gridDim.z;
    unsigned sum, cnt, mine, sp = 0u;
    for (;;) {
        sum = 0u; cnt = 0u; mine = 0u;
#pragma unroll
        for (unsigned j = 0; j < 16; ++j) { const unsigned c = xb_ld(&bar[XB_XCNT(j)]); sum += c; cnt += (c > 0u) ? 1u : 0u; mine = (j == x) ? c : mine; }
        if (sum == G) break;
        __builtin_amdgcn_s_sleep(1);
        if ((++sp & 255u) == 0u) { if (xb_ld(&bar[XB_TMO])) break; if (sp > XB_SPIN_CAP) { atomicAdd(&bar[XB_TMO], 1u); break; } }
    }
    nloc = mine > 0u ? mine : 1u; nx = cnt > 0u ? cnt : 1u;
}

__device__ __forceinline__ void xcd_barrier(const XcdBarrier& b) {
    asm volatile("s_waitcnt vmcnt(0)" ::: "memory");
    __syncthreads();
    if (threadIdx.x == 0) {
        unsigned* bar = b.bar;
        __builtin_amdgcn_s_waitcnt(0);
        unsigned nloc = b.st[0], nx = b.st[1];
        if (nloc == 0u) { xcd_barrier_complete(bar, b.x, nloc, nx); b.st[0] = nloc; b.st[1] = nx; }
        const unsigned old = xb_add(&bar[XB_XSUB(b.x)], 1u);
        const unsigned gen = old / nloc;
        if (old + 1u == (gen + 1u) * nloc) {
            __builtin_amdgcn_fence(__ATOMIC_RELEASE, "agent");
            asm volatile("s_waitcnt vmcnt(0)" ::: "memory");
            const unsigned og = xb_add(&bar[XB_TOP], 1u);
            const unsigned tg = og / nx;
            if (og + 1u == (tg + 1u) * nx) xb_add(&bar[XB_TOPGEN], 1u);
            else XB_SPIN(xb_ld(&bar[XB_TOPGEN]) == tg, bar);
            __builtin_amdgcn_fence(__ATOMIC_ACQUIRE, "agent");
            xb_add(&bar[XB_XGEN(b.x)], 1u);
            asm volatile("s_waitcnt vmcnt(0)" ::: "memory");
        } else {
            XB_SPIN(xb_ld(&bar[XB_XGEN(b.x)]) == gen, bar);
            __builtin_amdgcn_fence(__ATOMIC_ACQUIRE, "agent");
            asm volatile("s_waitcnt vmcnt(0)" ::: "memory");
        }
    }
    __syncthreads();
}


__device__ const unsigned char BUCKET[3][132] = {
{11,11,11,11,11,11,11,11,11,11,11,11,11,11,11,10,10,10,10,10,10,10,10,10,10,10,10,10,10,10,10,10,10,10,10,10,10,10,9,9,9,9,9,9,9,9,9,9,9,9,8,8,8,8,8,8,8,7,6,5,4,3,2,1,0,17,18,19,20,21,22,23,24,24,24,24,24,24,24,25,25,25,25,25,25,25,25,25,25,25,25,26,26,26,26,26,26,26,26,26,26,26,26,26,26,26,26,26,26,26,26,26,26,26,27,27,27,27,27,27,27,27,27,27,27,27,27,27,27,0,0,0},
{13,13,13,13,13,13,13,13,13,13,13,13,13,13,13,13,13,13,13,13,13,13,13,12,12,12,12,12,12,12,12,12,12,12,12,12,12,12,12,12,12,12,11,11,11,11,11,11,11,11,11,11,10,10,10,10,10,10,9,9,9,8,8,4,0,20,24,24,25,25,25,26,26,26,26,26,26,27,27,27,27,27,27,27,27,27,27,28,28,28,28,28,28,28,28,28,28,28,28,28,28,28,28,28,28,28,29,29,29,29,29,29,29,29,29,29,29,29,29,29,29,29,29,29,29,29,29,29,29,0,0,0},
{15,15,15,15,15,15,15,15,15,15,15,15,15,15,15,15,15,15,15,15,15,15,15,15,15,15,15,15,15,15,14,14,14,14,14,14,14,14,14,14,14,14,14,14,14,13,13,13,13,13,13,13,13,13,12,12,12,12,12,11,11,10,10,9,0,25,26,26,27,27,28,28,28,28,28,29,29,29,29,29,29,29,29,29,30,30,30,30,30,30,30,30,30,30,30,30,30,30,30,31,31,31,31,31,31,31,31,31,31,31,31,31,31,31,31,31,31,31,31,31,31,31,31,31,31,31,31,31,31,0,0,0}};

struct Frame {
    LAS unsigned char* lds;
    unsigned char* ldsg;
    volatile LAS unsigned* MISC;
    gu32* ctl;
    int tid, lane, wave;
    int vcu, G;
    const float* in[19]; float* out; unsigned char* ws;
};
#define WSP(F, type, off) ((type*)((F).ws + (off)))

__device__ __forceinline__ int src_col(int kind, int n) {
    if (kind == 1) { if (n < 3072) return n; if (n < 3328) return 3096 + (n - 3072); if (n < 3352) return 3072 + (n - 3328); return -1; }
    if (kind == 2) { const int t = n >> 8, h = (n >> 7) & 1, c = n & 127; return h * DFF + 128 * t + c; }
    return n;
}
__device__ __forceinline__ void transpose_w(Frame& F, const float* W, int K, int Nsrc, bf16* WT, int Ndst, int kind) {
    float* scr = (float*)(F.ldsg + F.wave * 16384);
    const int gw = F.vcu * NWAVES + F.wave, NGW = F.G * NWAVES, lane = F.lane;
    const int nblk = Ndst / 32, nitems = (K / 64) * nblk;
    for (int it = gw; it < nitems; it += NGW) {
        const int kb = it / nblk, nb = it % nblk, k0 = 64 * kb, n0 = 32 * nb;
        const int sc = src_col(kind, n0 + (lane & 31));
#pragma unroll 8
        for (int i = 0; i < 32; ++i) { const int kk = 2 * i + (lane >> 5); scr[kk * 33 + (lane & 31)] = sc >= 0 ? W[(size_t)(k0 + kk) * Nsrc + sc] : 0.f; }
        LDS_WAIT(); asm volatile("" ::: "memory");
        const int c = lane & 7;
#pragma unroll
        for (int j = 0; j < 4; ++j) { const int n = (lane >> 3) + 8 * j; const float* s = scr + (8 * c) * 33 + n;
            v4u o; o.x = pk2(s[0 * 33], s[1 * 33]); o.y = pk2(s[2 * 33], s[3 * 33]); o.z = pk2(s[4 * 33], s[5 * 33]); o.w = pk2(s[6 * 33], s[7 * 33]);
            *(v4u*)(WT + (size_t)(n0 + n) * K + k0 + 8 * c) = o; }
        LDS_WAIT(); asm volatile("" ::: "memory");
    }
}
__device__ __forceinline__ void rms_rows_bf16(Frame& F, const float* src, const float* gain, bf16* dst, int nrows) {
    const int gw = F.vcu * NWAVES + F.wave, NGW = F.G * NWAVES, lane = F.lane;
    for (int m = gw; m < nrows; m += NGW) {
        const f32x4* xr = (const f32x4*)(src + (size_t)m * D) + lane; const f32x4* gr = (const f32x4*)gain + lane;
        f32x4 v[4]; float s = 0.f;
#pragma unroll
        for (int j = 0; j < 4; ++j) { v[j] = xr[64 * j]; s += (v[j].x * v[j].x + v[j].y * v[j].y) + (v[j].z * v[j].z + v[j].w * v[j].w); }
        const float r = 1.0f / sqrtf(wave_sum(s) * (1.f / D) + EPS);
        v2u* o8 = (v2u*)(dst + (size_t)m * D) + lane;
#pragma unroll
        for (int j = 0; j < 4; ++j) { const f32x4 g = gr[64 * j]; v2u w; w.x = pk2(v[j].x * r * g.x, v[j].y * r * g.y); w.y = pk2(v[j].z * r * g.z, v[j].w * r * g.w); o8[64 * j] = w; }
    }
}
__device__ __forceinline__ void row_pass(Frame& F, const float* xold, const float* Y, const float* g_post, float* xnew, const float* g_pre, bf16* xn) {
    const int gw = F.vcu * NWAVES + F.wave, NGW = F.G * NWAVES, lane = F.lane;
    for (int m = gw; m < T; m += NGW) {
        const f32x4* yr = (const f32x4*)(Y + (size_t)m * D) + lane; const f32x4* xr = (const f32x4*)(xold + (size_t)m * D) + lane;
        f32x4 y[4], x[4]; float s = 0.f;
#pragma unroll
        for (int j = 0; j < 4; ++j) { y[j] = yr[64 * j]; x[j] = xr[64 * j]; s += (y[j].x * y[j].x + y[j].y * y[j].y) + (y[j].z * y[j].z + y[j].w * y[j].w); }
        const float r = 1.0f / sqrtf(wave_sum(s) * (1.f / D) + EPS);
        f32x4* xo = (f32x4*)(xnew + (size_t)m * D) + lane; float s2 = 0.f;
#pragma unroll
        for (int j = 0; j < 4; ++j) { const f32x4 g = ((const f32x4*)g_post + lane)[64 * j]; x[j] = x[j] + y[j] * r * g; xo[64 * j] = x[j];
            s2 += (x[j].x * x[j].x + x[j].y * x[j].y) + (x[j].z * x[j].z + x[j].w * x[j].w); }
        if (g_pre) {
            const float r2 = 1.0f / sqrtf(wave_sum(s2) * (1.f / D) + EPS);
            v2u* o8 = (v2u*)(xn + (size_t)m * D) + lane;
#pragma unroll
            for (int j = 0; j < 4; ++j) { const f32x4 g = ((const f32x4*)g_pre + lane)[64 * j]; v2u w; w.x = pk2(x[j].x * r2 * g.x, x[j].y * r2 * g.y); w.y = pk2(x[j].z * r2 * g.z, x[j].w * r2 * g.w); o8[64 * j] = w; }
        }
    }
}

__device__ __forceinline__ void attn_band_naive(Frame& F) {
    const int gw = F.vcu * NWAVES + F.wave, NGW = F.G * NWAVES, lane = F.lane;
    const bf16* PR = WSP(F, const bf16, WS_BIG); bf16* MIX = WSP(F, bf16, WS_MIX); float* LSE = WSP(F, float, WS_LSE);
    const float* rel_bias = F.in[2];
    for (int task = gw; task < T * NHEAD_A; task += NGW) {
        const int t = task / NHEAD_A, head = task % NHEAD_A, g = head >> 2, dil = 1 << (2 * g), b = t >> 12, s = t & (SEQ - 1);
        const float qv = bf2f(PR[(size_t)t * ATT_IN + head * 64 + lane]);
        float lg[3]; bool val[3];
#pragma unroll
        for (int pass = 0; pass < 3; ++pass) {
            const int ji = lane + 64 * pass, pos = s + (ji - 64) * dil; const bool valid = (ji <= 128) && pos >= 0 && pos < SEQ;
            const bf16* krow = PR + (size_t)(b * SEQ + (valid ? pos : s)) * ATT_IN + TOKW + head * 64;
            float dot = 0.f;
#pragma unroll
            for (int d8 = 0; d8 < 8; ++d8) { const v4u kk = *(const v4u*)(krow + 8 * d8);
                dot += bflo(kk.x) * __shfl(qv, 8 * d8 + 0) + bfhi(kk.x) * __shfl(qv, 8 * d8 + 1) + bflo(kk.y) * __shfl(qv, 8 * d8 + 2) + bfhi(kk.y) * __shfl(qv, 8 * d8 + 3)
                     + bflo(kk.z) * __shfl(qv, 8 * d8 + 4) + bfhi(kk.z) * __shfl(qv, 8 * d8 + 5) + bflo(kk.w) * __shfl(qv, 8 * d8 + 6) + bfhi(kk.w) * __shfl(qv, 8 * d8 + 7); }
            const int jc = ji <= 128 ? ji : 128;
            lg[pass] = valid ? dot * 0.125f + rel_bias[(int)BUCKET[g][jc] * NHEAD_A + head] : -1e30f; val[pass] = valid;
        }
        const float mx = wave_max(fmaxf(fmaxf(lg[0], lg[1]), lg[2]));
        float p[3];
#pragma unroll
        for (int pass = 0; pass < 3; ++pass) p[pass] = val[pass] ? __expf(lg[pass] - mx) : 0.f;
        const float den = wave_sum(p[0] + p[1] + p[2]);
        float o = 0.f;
        const bf16* vbase = PR + (size_t)(b * SEQ) * ATT_IN + 2 * TOKW + head * 64 + lane;
        for (int ji = 0; ji < 129; ++ji) {
            const int pos = s + (ji - 64) * dil; if (pos < 0 || pos >= SEQ) continue;
            const float pj = __shfl(ji < 64 ? p[0] : (ji < 128 ? p[1] : p[2]), ji & 63);
            o += pj * bf2f(vbase[(size_t)pos * ATT_IN]);
        }
        MIX[(size_t)t * D + head * 64 + lane] = (bf16)f2bf(o / den);
        if (lane == 0) LSE[(size_t)t * NHEAD_A + head] = mx + __logf(den);
    }
}
__device__ __forceinline__ void attn_mem_naive(Frame& F, const bf16* qsrc, int qpitch, const bf16* KV, int vb, int nvb) {
    const int gw = vb * NWAVES + F.wave, NGW = nvb * NWAVES, lane = F.lane;
    bf16* MIX = WSP(F, bf16, WS_MIX);
    for (int task = gw; task < T * 4; task += NGW) {
        const int t = task >> 2, mh = task & 3, b = t >> 12;
        const float qv = bf2f(qsrc[(size_t)t * qpitch + mh * 64 + lane]);
        float lg[4];
#pragma unroll
        for (int pass = 0; pass < 4; ++pass) {
            const bf16* krow = KV + (size_t)(b * MEML + lane + 64 * pass) * 512 + mh * 64;
            float dot = 0.f;
#pragma unroll
            for (int d8 = 0; d8 < 8; ++d8) { const v4u kk = *(const v4u*)(krow + 8 * d8);
                dot += bflo(kk.x) * __shfl(qv, 8 * d8 + 0) + bfhi(kk.x) * __shfl(qv, 8 * d8 + 1) + bflo(kk.y) * __shfl(qv, 8 * d8 + 2) + bfhi(kk.y) * __shfl(qv, 8 * d8 + 3)
                     + bflo(kk.z) * __shfl(qv, 8 * d8 + 4) + bfhi(kk.z) * __shfl(qv, 8 * d8 + 5) + bflo(kk.w) * __shfl(qv, 8 * d8 + 6) + bfhi(kk.w) * __shfl(qv, 8 * d8 + 7); }
            lg[pass] = dot * 0.125f;
        }
        const float mx = wave_max(fmaxf(fmaxf(lg[0], lg[1]), fmaxf(lg[2], lg[3])));
        float p[4];
#pragma unroll
        for (int pass = 0; pass < 4; ++pass) p[pass] = __expf(lg[pass] - mx);
        const float den = wave_sum((p[0] + p[1]) + (p[2] + p[3]));
        float o = 0.f;
        const bf16* vbase = KV + (size_t)(b * MEML) * 512 + 256 + mh * 64 + lane;
        for (int m = 0; m < MEML; ++m) {
            const float pj = __shfl(m < 64 ? p[0] : (m < 128 ? p[1] : (m < 192 ? p[2] : p[3])), m & 63);
            o += pj * bf2f(vbase[(size_t)m * 512]);
        }
        MIX[(size_t)t * D + TOKW + mh * 64 + lane] = (bf16)f2bf(o / den);
    }
}
__device__ __forceinline__ void lse_mix(Frame& F) {
    const int gw = F.vcu * NWAVES + F.wave, NGW = F.G * NWAVES, lane = F.lane;
    bf16* MIX = WSP(F, bf16, WS_MIX); const float* LSE = WSP(F, const float, WS_LSE);
    for (int t = gw; t < T; t += NGW) {
        float w[12];
#pragma unroll
        for (int j = 0; j < 4; ++j) { const float l0 = LSE[(size_t)t * 12 + j], l1 = LSE[(size_t)t * 12 + 4 + j], l2 = LSE[(size_t)t * 12 + 8 + j];
            const float mx = fmaxf(l0, fmaxf(l1, l2)); const float e0 = __expf(l0 - mx), e1 = __expf(l1 - mx), e2 = __expf(l2 - mx), inv = 1.0f / (e0 + e1 + e2);
            w[j] = e0 * inv; w[4 + j] = e1 * inv; w[8 + j] = e2 * inv; }
        bf16* row = MIX + (size_t)t * D + lane;
#pragma unroll
        for (int h = 0; h < 12; ++h) row[64 * h] = (bf16)f2bf(bf2f(row[64 * h]) * w[h]);
    }
}

__device__ __forceinline__ void dn_naive(Frame& F, int chain) {
    const int b = chain / 12, h = (chain >> 1) % 6, dir = chain & 1, tid = F.tid, lane = F.lane, wave = F.wave;
    const bf16* P = WSP(F, const bf16, WS_BIG); const float* GATE = WSP(F, const float, WS_GATE); float* O = WSP(F, float, WS_Y);
    const float* conv_w = F.in[6]; const float a_neg = -__expf(F.in[7][dir * 6 + h]); const float dtb = F.in[8][dir * 6 + h];
    float* qs = (float*)F.ldsg; float* ks = qs + 64 * 128; float* vs = ks + 64 * 128; float* gl = vs + 64 * 128; float* bl = gl + 64;
    float S[128];
#pragma unroll
    for (int i = 0; i < 128; ++i) S[i] = 0.f;
    for (int cc = 0; cc < NCHUNK; ++cc) {
        const int c = dir ? (NCHUNK - 1 - cc) : cc; const int s0 = c * CH; const size_t t0 = (size_t)b * SEQ + s0;
        __syncthreads();
        for (int idx = tid; idx < 64 * 384; idx += NWAVES * 64) {
            const int tok = idx / 384, ch = idx % 384, which = ch >> 7, d = ch & 127, col = which * TOKW + h * DNH + d;
            float acc = 0.f;
#pragma unroll
            for (int k = 0; k < 5; ++k) { const int s = s0 + tok + k - 2; if (s >= 0 && s < SEQ) acc += bf2f(P[((size_t)b * SEQ + s) * 2304 + col]) * conv_w[k * 2304 + col]; }
            qs[which * 8192 + tok * 128 + d] = silu(acc);
        }
        if (tid < 64) { const size_t t = t0 + tid; const float gi = GATE[t * 24 + dir * 12 + h] + dtb, bi = GATE[t * 24 + dir * 12 + 6 + h];
            const float sp = gi > 20.f ? gi : log1pf(__expf(gi)); gl[tid] = a_neg * sp; bl[tid] = 1.0f / (1.0f + __expf(-bi)); }
        __syncthreads();
#pragma unroll 1
        for (int i = 0; i < 8; ++i) { const int tok = wave * 8 + i;
            const float q0 = qs[tok * 128 + lane], q1 = qs[tok * 128 + 64 + lane], k0 = ks[tok * 128 + lane], k1 = ks[tok * 128 + 64 + lane];
            const float rq = 0.08838834764831845f / sqrtf(wave_sum(q0 * q0 + q1 * q1) + EPS), rk = 1.0f / sqrtf(wave_sum(k0 * k0 + k1 * k1) + EPS);
            qs[tok * 128 + lane] = q0 * rq; qs[tok * 128 + 64 + lane] = q1 * rq; ks[tok * 128 + lane] = k0 * rk; ks[tok * 128 + 64 + lane] = k1 * rk; }
        __syncthreads();
        if (tid < 128) {
            const int j = tid;
#pragma unroll 1
            for (int i = 0; i < CH; ++i) {
                const int p = dir ? (CH - 1 - i) : i;
                const float eg = __expf(gl[p]), bt = bl[p], vj = vs[p * 128 + j];
                const f32x4* kp = (const f32x4*)(ks + p * 128); const f32x4* qp = (const f32x4*)(qs + p * 128);
                float r0 = 0.f, r1 = 0.f, r2 = 0.f, r3 = 0.f;
#pragma unroll
                for (int i4 = 0; i4 < 32; ++i4) { const f32x4 kv = kp[i4]; r0 += kv.x * S[4 * i4]; r1 += kv.y * S[4 * i4 + 1]; r2 += kv.z * S[4 * i4 + 2]; r3 += kv.w * S[4 * i4 + 3]; if ((i4 & 3) == 3) asm volatile("" ::: "memory"); }
                const float r = (r0 + r1) + (r2 + r3);
                const float c1 = bt * (vj - eg * r);
                float o0 = 0.f, o1 = 0.f, o2 = 0.f, o3 = 0.f;
#pragma unroll
                for (int i4 = 0; i4 < 32; ++i4) { const f32x4 kv = kp[i4], qv = qp[i4];
                    S[4 * i4] = eg * S[4 * i4] + kv.x * c1; S[4 * i4 + 1] = eg * S[4 * i4 + 1] + kv.y * c1; S[4 * i4 + 2] = eg * S[4 * i4 + 2] + kv.z * c1; S[4 * i4 + 3] = eg * S[4 * i4 + 3] + kv.w * c1;
                    o0 += qv.x * S[4 * i4]; o1 += qv.y * S[4 * i4 + 1]; o2 += qv.z * S[4 * i4 + 2]; o3 += qv.w * S[4 * i4 + 3]; if ((i4 & 3) == 3) asm volatile("" ::: "memory"); }
                atomicAdd(O + (t0 + p) * TOKW + h * DNH + j, (o0 + o1) + (o2 + o3));
            }
        }
    }
}
__device__ __forceinline__ void dn_gate(Frame& F) {
    const int gw = F.vcu * NWAVES + F.wave, NGW = F.G * NWAVES, lane = F.lane;
    bf16* MIX = WSP(F, bf16, WS_MIX); const float* O = WSP(F, const float, WS_Y); const float* onorm = F.in[9];
    const float n0 = onorm[lane], n1 = onorm[64 + lane];
    for (int t = gw; t < T; t += NGW) {
#pragma unroll
        for (int h = 0; h < NHEAD_D; ++h) {
            const float o0 = O[(size_t)t * TOKW + h * DNH + lane], o1 = O[(size_t)t * TOKW + h * DNH + 64 + lane];
            const float r = 1.0f / sqrtf(wave_sum(o0 * o0 + o1 * o1) * (1.f / DNH) + EPS);
            bf16* zp = MIX + (size_t)t * D + h * DNH + lane;
            const float z0 = bf2f(zp[0]), z1 = bf2f(zp[64]);
            zp[0] = (bf16)f2bf(o0 * r * n0 * silu(z0)); zp[64] = (bf16)f2bf(o1 * r * n1 * silu(z1));
        }
    }
}
__device__ __forceinline__ void zero_f32(Frame& F, float* p, size_t n4) {
    const size_t gt = (size_t)F.vcu * (NWAVES * 64) + F.tid, NT = (size_t)F.G * (NWAVES * 64);
    for (size_t i = gt; i < n4; i += NT) ((f32x4*)p)[i] = (f32x4){0.f, 0.f, 0.f, 0.f};
}

struct Args { const float* in[19]; float* out; unsigned char* ws; int ph_lo, ph_hi; };
__global__ void __launch_bounds__(NWAVES * 64, 2) mk_fwd(Args args) {
    extern __shared__ __attribute__((aligned(16))) unsigned char lds[];
    Frame F;
    F.lds = (LAS unsigned char*)lds; F.ldsg = lds;
    F.MISC = (volatile LAS unsigned*)(F.lds + MISC_OFF);
    F.tid = threadIdx.x; F.lane = F.tid & 63; F.wave = __builtin_amdgcn_readfirstlane(F.tid >> 6);
    F.G = gridDim.x; { const int bx = blockIdx.x; F.vcu = (F.G % 8 == 0) ? (bx % 8) * (F.G / 8) + bx / 8 : bx; }
    F.ws = args.ws; F.out = args.out;
#pragma unroll
    for (int i = 0; i < 19; ++i) F.in[i] = args.in[i];
    F.ctl = (gu32*)(F.ws + WS_CTL);
    for (int u = F.tid; u < (LDS_BYTES - LDSCTL_OFF) / 4; u += NWAVES * 64) ((LAS unsigned*)(F.lds + LDSCTL_OFF))[u] = 0u;
    __syncthreads();
    XcdBarrier bar; bar.bar = (unsigned*)(F.ctl + CW_BAR); bar.x = 0; bar.st = nullptr;
    if (N_LAUNCHES == 1) bar = xcd_barrier_post((unsigned*)(F.ctl + CW_BAR), F.MISC + 8);
#define GRID_BAR() do { if (N_LAUNCHES == 1) xcd_barrier(bar); } while (0)
    const int lo = args.ph_lo, hi = args.ph_hi;
#define IN(k) (lo <= (k) && (k) < hi)
#define BOTH(k) (IN(k) && IN((k) + 1))
#define SEAM(k) do { if (BOTH(k)) GRID_BAR(); } while (0)
    bf16* XN = WSP(F, bf16, WS_XN); bf16* MIX = WSP(F, bf16, WS_MIX); float* Y = WSP(F, float, WS_Y); bf16* BIG = WSP(F, bf16, WS_BIG);

    if (IN(0)) {
        transpose_w(F, F.in[3], D, ATT_IN, WSP(F, bf16, WS_W_ATT_IN), ATT_IN, 0);
        transpose_w(F, F.in[4], D, D, WSP(F, bf16, WS_W_ATT_OUT), D, 0);
        transpose_w(F, F.in[5], D, DN_IN, WSP(F, bf16, WS_W_DN_IN), DN_IN_P, 1);
        transpose_w(F, F.in[10], D, D, WSP(F, bf16, WS_W_DN_OUT), D, 0);
        for (int i = 0; i < 2; ++i) {
            transpose_w(F, F.in[12] + (size_t)i * D * 512, D, 512, WSP(F, bf16, WS_W_MEMKV) + (size_t)i * 512 * D, 512, 0);
            transpose_w(F, F.in[17] + (size_t)i * D * GU, D, GU, WSP(F, bf16, WS_W_GU) + (size_t)i * GU * D, GU, 2);
            transpose_w(F, F.in[18] + (size_t)i * DFF * D, DFF, D, WSP(F, bf16, WS_W_DOWN) + (size_t)i * D * DFF, D, 0);
            rms_rows_bf16(F, F.in[1], F.in[11] + i * D, WSP(F, bf16, WS_MEMN) + (size_t)i * NB * MEML * D, NB * MEML);
        }
        rms_rows_bf16(F, F.in[0], F.in[13], XN, T);
        SEAM(0);
    }
    if (IN(1)) {
        { pg8::Gemm g{XN, WSP(F, bf16, WS_W_ATT_IN), T, ATT_IN, D}; pg8::StaticOrder S; S.init(T, ATT_IN, F.G, (int)blockIdx.x);
          pg8::EpiRoute E{0, BIG, ATT_IN, nullptr, 0, nullptr};
          pg8::gemm_phase<pg8::EpiRoute, pg8::StaticOrder, PG8_ALIGN, PG8_SP2>(F.lds + RING_OFF, g, S, E); }
        for (int i = 0; i < 2; ++i) {
            pg8::Gemm g{WSP(F, bf16, WS_MEMN) + (size_t)i * NB * MEML * D, WSP(F, bf16, WS_W_MEMKV) + (size_t)i * 512 * D, NB * MEML, 512, D};
            pg8::StaticOrder S; S.init(NB * MEML, 512, F.G, (int)((blockIdx.x + 64 * (i + 1)) % F.G));
            pg8::EpiRoute E{0, WSP(F, bf16, WS_MEMKV) + (size_t)i * NB * MEML * 512, 512, nullptr, 0, nullptr};
            pg8::gemm_phase<pg8::EpiRoute, pg8::StaticOrder, PG8_ALIGN, PG8_SP2>(F.lds + RING_OFF, g, S, E);
        }
        SEAM(1);
    }
    if (IN(2)) {
        attn_band_naive(F);
        attn_mem_naive(F, BIG + 3 * TOKW, ATT_IN, WSP(F, const bf16, WS_MEMKV), F.vcu, F.G);
        SEAM(2);
    }
    if (IN(3)) { lse_mix(F); SEAM(3); }
#define GEMM_OUT(WOFF) do { pg8::Gemm g{MIX, WSP(F, bf16, WOFF), T, D, D}; pg8::StaticOrder S; S.init(T, D, F.G, (int)blockIdx.x); pg8::EpiF32 E{Y, D}; \
        pg8::gemm_phase<pg8::EpiF32, pg8::StaticOrder, PG8_ALIGN, PG8_SP2>(F.lds + RING_OFF, g, S, E); } while (0)
#define GEMM_GU(i) do { pg8::Gemm g{XN, WSP(F, bf16, WS_W_GU) + (size_t)(i) * GU * D, T, GU, D}; pg8::StaticOrder S; S.init(T, GU, F.G, (int)blockIdx.x); pg8::EpiSwiglu E{BIG, DFF}; \
        pg8::gemm_phase<pg8::EpiSwiglu, pg8::StaticOrder, PG8_ALIGN, PG8_SP2>(F.lds + RING_OFF, g, S, E); } while (0)
#define GEMM_DOWN(i) do { pg8::Gemm g{BIG, WSP(F, bf16, WS_W_DOWN) + (size_t)(i) * D * DFF, T, D, DFF}; pg8::StaticOrder S; S.init(T, D, F.G, (int)blockIdx.x); pg8::EpiF32 E{Y, D}; \
        pg8::gemm_phase<pg8::EpiF32, pg8::StaticOrder, PG8_ALIGN, PG8_SP2>(F.lds + RING_OFF, g, S, E); } while (0)
    if (IN(4)) { GEMM_OUT(WS_W_ATT_OUT); SEAM(4); }
    if (IN(5)) { row_pass(F, F.in[0], Y, F.in[14], F.out, F.in[15], XN); SEAM(5); }
    if (IN(6)) { GEMM_GU(0); SEAM(6); }
    if (IN(7)) { GEMM_DOWN(0); SEAM(7); }
    if (IN(8)) { row_pass(F, F.out, Y, F.in[16], F.out, F.in[13] + D, XN); SEAM(8); }
    if (IN(9)) {
        zero_f32(F, Y, (size_t)T * TOKW / 4);
        pg8::Gemm g{XN, WSP(F, bf16, WS_W_DN_IN), T, DN_IN_P, D}; pg8::StaticOrder S; S.init(T, DN_IN_P, F.G, (int)blockIdx.x);
        pg8::EpiRoute E{1, BIG, 3 * TOKW, MIX, D, WSP(F, float, WS_GATE)};
        pg8::gemm_phase<pg8::EpiRoute, pg8::StaticOrder, PG8_ALIGN, PG8_SP2>(F.lds + RING_OFF, g, S, E);
        SEAM(9);
    }
    if (IN(10)) {
        const bool split = F.G >= 192;
#pragma unroll 1
        for (int c = F.vcu; c < 96; c += F.G) dn_naive(F, c);
        if (!split || F.vcu >= 96) attn_mem_naive(F, MIX + TOKW, D, WSP(F, const bf16, WS_MEMKV) + (size_t)NB * MEML * 512, split ? F.vcu - 96 : F.vcu, split ? F.G - 96 : F.G);
        SEAM(10);
    }
    if (IN(11)) { dn_gate(F); SEAM(11); }
    if (IN(12)) { GEMM_OUT(WS_W_DN_OUT); SEAM(12); }
    if (IN(13)) { row_pass(F, F.out, Y, F.in[14] + D, F.out, F.in[15] + D, XN); SEAM(13); }
    if (IN(14)) { GEMM_GU(1); SEAM(14); }
    if (IN(15)) { GEMM_DOWN(1); SEAM(15); }
    if (IN(16)) { row_pass(F, F.out, Y, F.in[16] + D, F.out, nullptr, nullptr); }
#undef IN
#undef BOTH
}

extern "C" void kernel_launch(void* const* d_in, const int* in_sizes, int n_in, void* d_out, int out_size, void* d_ws, size_t ws_size, hipStream_t stream) {
    static int grid = 0;
    if (grid == 0) {
        if (n_in != 19 || in_sizes[0] != T * D || out_size != T * D || ws_size < WS_END) { fprintf(stderr, "kernel_launch: unexpected shapes (n_in %d, in0 %d, out %d, ws %zu)\n", n_in, n_in > 0 ? in_sizes[0] : -1, out_size, ws_size); grid = -1; return; }
        int dev = 0, cus = 0, per_cu = 0;
        if (hipGetDevice(&dev) != hipSuccess || hipDeviceGetAttribute(&cus, hipDeviceAttributeMultiprocessorCount, dev) != hipSuccess) { grid = -1; return; }
        if (hipFuncSetAttribute((const void*)mk_fwd, hipFuncAttributeMaxDynamicSharedMemorySize, LDS_BYTES) != hipSuccess) { fprintf(stderr, "kernel_launch: hipFuncSetAttribute failed\n"); grid = -1; return; }
        if (hipOccupancyMaxActiveBlocksPerMultiprocessor(&per_cu, (const void*)mk_fwd, NWAVES * 64, LDS_BYTES) != hipSuccess || per_cu < 1)
            fprintf(stderr, "kernel_launch: note: occupancy query reports %d workgroups per CU\n", per_cu);
        (void)hipGetLastError();
        grid = cus;
    }
    if (grid < 0) return;
    if (hipMemsetAsync((char*)d_ws + WS_CTL, 0, CTL_ZERO_BYTES, stream) != hipSuccess) { fprintf(stderr, "kernel_launch: hipMemsetAsync failed\n"); return; }
    Args a{};
    for (int i = 0; i < 19; ++i) a.in[i] = (const float*)d_in[i];
    a.out = (float*)d_out; a.ws = (unsigned char*)d_ws;
    for (int li = 0; li < N_LAUNCHES; ++li) {
        a.ph_lo = (N_LAUNCHES == 1) ? 0 : li; a.ph_hi = (N_LAUNCHES == 1) ? N_PHASES : li + 1;
        hipLaunchKernelGGL(mk_fwd, dim3(grid), dim3(NWAVES * 64), LDS_BYTES, stream, a);
        const hipError_t le = hipPeekAtLastError();
        if (le != hipSuccess) { fprintf(stderr, "kernel_launch: launch %d failed: %s\n", li, hipGetErrorName(le)); break; }
    }
}
```

```cpp
#include <hip/hip_runtime.h>
#include <cstdio>
#include <cstdint>
#define MK_N_LAUNCHES 1
namespace pg8 {
#define PG8_LAS __attribute__((address_space(3)))
typedef unsigned short bf16_t;
typedef short bf16x8 __attribute__((ext_vector_type(8)));
typedef float f32x4 __attribute__((ext_vector_type(4)));
typedef unsigned u32x4 __attribute__((ext_vector_type(4)));
constexpr int BM = 256, BK = 64, HALF = 128, HTB = HALF * BK * 2  , STAGE_BYTES = 8 * HTB, NXCD = 8, WGM = 8;

__host__ __device__ __forceinline__ int lds_byte(int r, int c) { const int st = (r >> 4) * 2 + (c >> 5), rr = r & 15, cc = c & 31, ob = rr * 64 + cc * 2; return st * 1024 + (ob ^ (((ob >> 9) & 1) << 5)); }
__host__ __device__ __forceinline__ void stage_rc(int b, int& R, int& C) { const int st = b / 1024, sb = b % 1024, swz = sb ^ (((sb >> 9) & 1) << 5); R = (st >> 1) * 16 + swz / 64; C = (st & 1) * 32 + (swz % 64) / 2; }
__host__ __device__ __forceinline__ int perm32(int rho) { const int n = rho >> 4, i = rho & 15; return 8 * (i >> 2) + 4 * n + (i & 3); }

struct Unit { int pm, pn; };
struct Gemm { const bf16_t* A; const bf16_t* Bt; int M, N, K; };

struct StaticOrder {
    int nM, nN, nwg, G, c;
    __host__ __device__ void init(int M, int N, int G_, int c_) { nM = M / BM; nN = N / BM; nwg = nM * nN; G = G_; c = c_; }
    __host__ __device__ bool next(int i, Unit& u) const {
        const long L = (long)i * G + c; if (L >= nwg) return false;
        int wgid = (int)L; { const int q = nwg / NXCD, r = nwg % NXCD, xcd = wgid % NXCD, off = wgid / NXCD; wgid = (xcd < r ? xcd * (q + 1) : r * (q + 1) + (xcd - r) * q) + off; }
        const int nig = WGM * nN, gid = wgid / nig, fm = gid * WGM, gsz = (nM - fm) < WGM ? (nM - fm) : WGM;
        u.pm = fm + ((wgid % nig) % gsz); u.pn = (wgid % nig) / gsz; return true;
    }
    __device__ __forceinline__ void a_ready(const Unit&) const {}
    __device__ __forceinline__ void done(const Unit&) const {}
};

__device__ __forceinline__ unsigned cvt_pk_bf16(float lo, float hi) { unsigned r; asm volatile("v_cvt_pk_bf16_f32 %0, %1, %2" : "=v"(r) : "v"(lo), "v"(hi)); return r; }
typedef float f32x2 __attribute__((ext_vector_type(2)));
struct EpiF32 {
    static constexpr bool PERM = false, AFTER_DRAIN = false;
    float* C; int ldc;
    __device__ __forceinline__ void operator()(const f32x4 (&acc)[2][2][4][2], const Unit& u, int wr, int wc, int fr, int fq) const {
        const int row0 = u.pm * BM + wr * 64 + fr, col0 = u.pn * BM + wc * 32 + 4 * fq;
#pragma unroll
        for (int ai = 0; ai < 2; ++ai)
#pragma unroll
            for (int m = 0; m < 4; ++m) { float* rowp = C + (size_t)(row0 + ai * HALF + m * 16) * ldc + col0;
#pragma unroll
                for (int bj = 0; bj < 2; ++bj)
#pragma unroll
                    for (int n = 0; n < 2; ++n) *(f32x4*)(rowp + bj * HALF + n * 16) = acc[ai][bj][m][n]; }
    }
};
struct EpiRoute {
    static constexpr bool PERM = true, AFTER_DRAIN = false;
    int mode; bf16_t* O; int ldc; bf16_t* O2; int ldc2; float* gate;
    __device__ __forceinline__ void operator()(const f32x4 (&acc)[2][2][4][2], const Unit& u, int wr, int wc, int fr, int fq) const {
        const int row0 = u.pm * BM + wr * 64 + fr;
        if (mode == 1 && u.pn == 13) {
            if (wc == 0 && fq < 3) {
#pragma unroll
                for (int ai = 0; ai < 2; ++ai)
#pragma unroll
                    for (int m = 0; m < 4; ++m) { float* rowp = gate + (size_t)(row0 + ai * HALF + m * 16) * 24 + 8 * fq;
                        *(f32x4*)(rowp) = acc[ai][0][m][0]; *(f32x4*)(rowp + 4) = acc[ai][0][m][1]; }
            }
            return;
        }
        bf16_t* base = O; int ld = ldc; int colt = u.pn * BM;
        if (mode == 1 && u.pn >= 9) { base = O2; ld = ldc2; colt = (u.pn - 9) * BM; }
        const int col0 = colt + wc * 32 + 8 * fq;
#pragma unroll
        for (int ai = 0; ai < 2; ++ai)
#pragma unroll
            for (int m = 0; m < 4; ++m) { bf16_t* rowp = base + (size_t)(row0 + ai * HALF + m * 16) * ld + col0;
#pragma unroll
                for (int bj = 0; bj < 2; ++bj) { const f32x4 v0 = acc[ai][bj][m][0], v1 = acc[ai][bj][m][1];
                    u32x4 w; w.x = cvt_pk_bf16(v0[0], v0[1]); w.y = cvt_pk_bf16(v0[2], v0[3]); w.z = cvt_pk_bf16(v1[0], v1[1]); w.w = cvt_pk_bf16(v1[2], v1[3]);
                    *(u32x4*)(rowp + bj * HALF) = w; } }
    }
};
__device__ __forceinline__ float silu_f(float x) { return x * __builtin_amdgcn_rcpf(1.0f + __expf(-x)); }
struct EpiSwiglu {
    static constexpr bool PERM = true, AFTER_DRAIN = false;
    bf16_t* H; int ldh;
    __device__ __forceinline__ void operator()(const f32x4 (&acc)[2][2][4][2], const Unit& u, int wr, int wc, int fr, int fq) const {
        const int row0 = u.pm * BM + wr * 64 + fr, col0 = u.pn * HALF + wc * 32 + 8 * fq;
#pragma unroll
        for (int ai = 0; ai < 2; ++ai)
#pragma unroll
            for (int m = 0; m < 4; ++m) { bf16_t* rowp = H + (size_t)(row0 + ai * HALF + m * 16) * ldh + col0;
                const f32x4 g0 = acc[ai][0][m][0], g1 = acc[ai][0][m][1], u0 = acc[ai][1][m][0], u1 = acc[ai][1][m][1];
                u32x4 w; w.x = cvt_pk_bf16(silu_f(g0[0]) * u0[0], silu_f(g0[1]) * u0[1]); w.y = cvt_pk_bf16(silu_f(g0[2]) * u0[2], silu_f(g0[3]) * u0[3]);
                w.z = cvt_pk_bf16(silu_f(g1[0]) * u1[0], silu_f(g1[1]) * u1[1]); w.w = cvt_pk_bf16(silu_f(g1[2]) * u1[2], silu_f(g1[3]) * u1[3]);
                *(u32x4*)(rowp) = w; }
    }
};

template <class Epi, class Sched, bool ALIGN_EPI = false, bool SP2 = false>
__device__ __forceinline__ void gemm_phase(PG8_LAS unsigned char* lds, const Gemm g, const Sched& S, const Epi& E) {
    int tid_ = threadIdx.x; asm volatile("" : "+v"(tid_));
    const int tid = tid_, wid = __builtin_amdgcn_readfirstlane(tid >> 6), lane = tid & 63, wr = wid >> 2, wc = wid & 3, fr = lane & 15, fq = lane >> 4;
    const int K = g.K, nt = K / BK;
    unsigned voffA[2], voffB[2];
#pragma unroll
    for (int i = 0; i < 2; ++i) { int R, C; stage_rc(tid * 16 + i * 8192, R, C); const int Rb = Epi::PERM ? ((R & ~31) + perm32(R & 31)) : R;
        voffA[i] = (unsigned)(R * K + C) * 2u; voffB[i] = (unsigned)(Rb * K + C) * 2u; }
    const size_t kstep = (size_t)(BK * 2);
    const size_t hstep = (size_t)HALF * K * 2;
    const size_t tstep = 2 * hstep;
    const unsigned ldsw = (unsigned)wid * 1024u;
    const int aoff = lds_byte(wr * 64 + fr, fq * 8), boff = lds_byte(wc * 32 + fr, fq * 8);
#define PG8_SA(b, h) (((b) * 2 + (h)) * HTB)
#define PG8_SB(b, h) ((4 + (b) * 2 + (h)) * HTB)
#define PG8_STAGE(bufoff, gbase, voff) do { _Pragma("unroll") for (int _i = 0; _i < 2; ++_i) \
        __builtin_amdgcn_global_load_lds((const unsigned*)((const char*)(gbase) + (voff)[_i]), (PG8_LAS unsigned*)(lds + (bufoff) + ldsw + _i * 8192), 16, 0, 0); } while (0)
#define PG8_LDA(dst, b, h) do { _Pragma("unroll") for (int m = 0; m < 4; ++m) _Pragma("unroll") for (int k = 0; k < 2; ++k) dst[m][k] = *(const PG8_LAS bf16x8*)(lds + PG8_SA(b, h) + aoff + m * 2048 + k * 1024); } while (0)
#define PG8_LDB(dst, b, h) do { _Pragma("unroll") for (int n = 0; n < 2; ++n) _Pragma("unroll") for (int k = 0; k < 2; ++k) dst[n][k] = *(const PG8_LAS bf16x8*)(lds + PG8_SB(b, h) + boff + n * 2048 + k * 1024); } while (0)
#define PG8_MMA(ai, bj, At, Bt) do { __builtin_amdgcn_s_setprio(1); _Pragma("unroll") for (int m = 0; m < 4; ++m) _Pragma("unroll") for (int n = 0; n < 2; ++n) _Pragma("unroll") for (int k = 0; k < 2; ++k) \
        acc[ai][bj][m][n] = __builtin_amdgcn_mfma_f32_16x16x32_bf16(Bt[n][k], At[m][k], acc[ai][bj][m][n], 0, 0, 0); __builtin_amdgcn_s_setprio(0); } while (0)
#define PG8_WAIT_V(n) asm volatile("s_waitcnt vmcnt(" #n ")" ::: "memory")
#define PG8_WAIT_L(n) asm volatile("s_waitcnt lgkmcnt(" #n ")" ::: "memory")
#define PG8_BAR __builtin_amdgcn_s_barrier()
#define PG8_SCHED __builtin_amdgcn_sched_barrier(0)
    Unit cur, nxt; int ui = 0;
    if (!S.next(0, cur)) return;
    f32x4 acc[2][2][4][2];
#pragma unroll
    for (int a = 0; a < 2; ++a)
#pragma unroll
        for (int b = 0; b < 2; ++b)
#pragma unroll
            for (int m = 0; m < 4; ++m)
#pragma unroll
                for (int n = 0; n < 2; ++n) acc[a][b][m][n] = (f32x4){0.f, 0.f, 0.f, 0.f};
    bf16x8 At[4][2], B0[2][2], B1[2][2];
    const char* cA = (const char*)g.A + (size_t)cur.pm * tstep; const char* cB = (const char*)g.Bt + (size_t)cur.pn * tstep;
    S.a_ready(cur);
    if constexpr (SP2) {
        PG8_STAGE(PG8_SB(0, 0), cB, voffB); PG8_STAGE(PG8_SB(0, 1), cB + hstep, voffB); PG8_STAGE(PG8_SA(0, 0), cA, voffA); PG8_STAGE(PG8_SA(0, 1), cA + hstep, voffA);
        if (wr == 1) PG8_BAR;
        PG8_WAIT_V(2); PG8_BAR;
        PG8_STAGE(PG8_SB(1, 0), cB + kstep, voffB); PG8_STAGE(PG8_SA(1, 0), cA + kstep, voffA); PG8_STAGE(PG8_SB(1, 1), cB + hstep + kstep, voffB);
        PG8_WAIT_V(6); PG8_BAR;
    } else {
        PG8_STAGE(PG8_SB(0, 0), cB, voffB); PG8_STAGE(PG8_SA(0, 0), cA, voffA); PG8_STAGE(PG8_SB(0, 1), cB + hstep, voffB); PG8_STAGE(PG8_SA(0, 1), cA + hstep, voffA);
        if (wr == 1) PG8_BAR;
        PG8_WAIT_V(4); PG8_BAR;
        PG8_STAGE(PG8_SB(1, 0), cB + kstep, voffB); PG8_STAGE(PG8_SA(1, 0), cA + kstep, voffA); PG8_STAGE(PG8_SB(1, 1), cB + hstep + kstep, voffB);
        PG8_WAIT_V(6); PG8_BAR;
    }
    for (;;) {
        const bool has_next = S.next(ui + 1, nxt);
        const char* nA = has_next ? (const char*)g.A + (size_t)nxt.pm * tstep : cA; const char* nB = has_next ? (const char*)g.Bt + (size_t)nxt.pn * tstep : cB;
        for (int t = 0; t < nt; t += 2) {
            const bool last = (t == nt - 2);
            const char* a1 = cA + (size_t)(t + 1) * kstep;
            const char* a2 = last ? nA : cA + (size_t)(t + 2) * kstep; const char* b2 = last ? nB : cB + (size_t)(t + 2) * kstep;
            const char* a3 = a2 + kstep; const char* b3 = b2 + kstep;
            if (last && has_next) S.a_ready(nxt);
            if constexpr (SP2) {
            PG8_LDB(B0, 0, 0); PG8_LDB(B1, 0, 1); PG8_SCHED; PG8_LDA(At, 0, 0); PG8_STAGE(PG8_SA(1, 1), a1 + hstep, voffA);
            PG8_WAIT_V(8); PG8_WAIT_L(0); PG8_BAR; PG8_MMA(0, 0, At, B0); PG8_MMA(0, 1, At, B1); PG8_BAR; PG8_SCHED;
            PG8_LDA(At, 0, 1); PG8_STAGE(PG8_SB(0, 0), b2, voffB); PG8_STAGE(PG8_SB(0, 1), b2 + hstep, voffB); PG8_STAGE(PG8_SA(0, 0), a2, voffA);
            PG8_WAIT_V(8); PG8_WAIT_L(0); PG8_BAR; PG8_MMA(1, 0, At, B0); PG8_MMA(1, 1, At, B1); PG8_BAR; PG8_SCHED;
            PG8_LDB(B0, 1, 0); PG8_LDB(B1, 1, 1); PG8_SCHED; PG8_LDA(At, 1, 0); PG8_STAGE(PG8_SA(0, 1), a2 + hstep, voffA);
            PG8_WAIT_V(8); PG8_WAIT_L(0); PG8_BAR; PG8_MMA(0, 0, At, B0); PG8_MMA(0, 1, At, B1); PG8_BAR; PG8_SCHED;
            PG8_LDA(At, 1, 1); PG8_STAGE(PG8_SB(1, 0), b3, voffB); PG8_STAGE(PG8_SB(1, 1), b3 + hstep, voffB); PG8_STAGE(PG8_SA(1, 0), a3, voffA);
            PG8_WAIT_V(8); PG8_WAIT_L(0); PG8_BAR; PG8_MMA(1, 0, At, B0); PG8_MMA(1, 1, At, B1); PG8_BAR; PG8_SCHED;
            } else {
            PG8_LDB(B0, 0, 0); PG8_SCHED; PG8_LDA(At, 0, 0); PG8_STAGE(PG8_SA(1, 1), a1 + hstep, voffA);
            PG8_WAIT_L(8); PG8_BAR; PG8_WAIT_L(0); PG8_MMA(0, 0, At, B0); PG8_BAR; PG8_SCHED;
            PG8_LDB(B1, 0, 1); PG8_STAGE(PG8_SB(0, 0), b2, voffB);
            PG8_BAR; PG8_WAIT_L(0); PG8_MMA(0, 1, At, B1); PG8_BAR;
            PG8_LDA(At, 0, 1); PG8_STAGE(PG8_SA(0, 0), a2, voffA);
            PG8_BAR; PG8_WAIT_L(0); PG8_MMA(1, 0, At, B0); PG8_BAR; PG8_SCHED;
            PG8_STAGE(PG8_SB(0, 1), b2 + hstep, voffB);
            PG8_WAIT_V(6); PG8_BAR; PG8_MMA(1, 1, At, B1); PG8_BAR;
            PG8_LDB(B0, 1, 0); PG8_SCHED; PG8_LDA(At, 1, 0); PG8_STAGE(PG8_SA(0, 1), a2 + hstep, voffA);
            PG8_WAIT_L(8); PG8_BAR; PG8_WAIT_L(0); PG8_MMA(0, 0, At, B0); PG8_BAR; PG8_SCHED;
            PG8_LDB(B1, 1, 1); PG8_STAGE(PG8_SB(1, 0), b3, voffB);
            PG8_BAR; PG8_WAIT_L(0); PG8_MMA(0, 1, At, B1); PG8_BAR;
            PG8_LDA(At, 1, 1); PG8_STAGE(PG8_SA(1, 0), a3, voffA);
            PG8_BAR; PG8_WAIT_L(0); PG8_MMA(1, 0, At, B0); PG8_BAR; PG8_SCHED;
            PG8_STAGE(PG8_SB(1, 1), b3 + hstep, voffB);
            PG8_WAIT_V(6); PG8_BAR; PG8_MMA(1, 1, At, B1); PG8_BAR;
            }
        }
        if constexpr (ALIGN_EPI) { if (wr == 0) PG8_BAR; }
        if constexpr (!Epi::AFTER_DRAIN) { E(acc, cur, wr, wc, fr, fq); S.done(cur); }
        if (!has_next) break;
#pragma unroll
        for (int a = 0; a < 2; ++a)
#pragma unroll
            for (int b = 0; b < 2; ++b)
#pragma unroll
                for (int m = 0; m < 4; ++m)
#pragma unroll
                    for (int n = 0; n < 2; ++n) acc[a][b][m][n] = (f32x4){0.f, 0.f, 0.f, 0.f};
        cur = nxt; cA = nA; cB = nB; ++ui;
        if constexpr (ALIGN_EPI) { if (wr == 1) PG8_BAR; }
    }
    PG8_WAIT_V(0);
    if constexpr (!ALIGN_EPI) { if (wr == 0) PG8_BAR; }
    PG8_BAR;
    if constexpr (Epi::AFTER_DRAIN) { E.fused(acc, cur, wr, wc, fr, fq, lds, wid, lane); S.done(cur); }
#undef PG8_SA
#undef PG8_SB
#undef PG8_STAGE
#undef PG8_LDA
#undef PG8_LDB
#undef PG8_MMA
#undef PG8_WAIT_V
#undef PG8_WAIT_L
#undef PG8_BAR
#undef PG8_SCHED
}
}
constexpr int NWAVES = 8;
#ifndef MK_N_LAUNCHES
#define MK_N_LAUNCHES 1
#endif
#ifndef MK_PROG
#define MK_PROG 0, 1, 2, 3, 4, 5, 6, 7, 5 | 16, 8, 11, 9, 10, 4 | 16, 5 | 32, 6 | 16, 7 | 16, 5 | 48
#endif
__device__ const int PROG[] = {MK_PROG};
constexpr int PROG_HOST[] = {MK_PROG};
constexpr int N_PHASES = sizeof(PROG_HOST) / sizeof(int);
constexpr int N_LAUNCHES = MK_N_LAUNCHES;
#ifndef PG8_SP2
#define PG8_SP2 true
#endif
#ifndef PG8_ALIGN
#define PG8_ALIGN true
#endif

constexpr int NB = 8, SEQ = 4096, D = 1024, T = NB * SEQ;
constexpr int TOKW = 768, MEMW = 256, MEML = 256;
constexpr int ATT_IN = 2560, DN_IN = 3352, DN_IN_P = 3584, DFF = 2816, GU = 2 * DFF;
constexpr int NHEAD_A = 12, NHEAD_D = 6, DNH = 128, NCHUNK = 64, CH = 64;
constexpr float EPS = 1e-6f;

constexpr size_t MiB = 1u << 20;
constexpr size_t WS_CTL = 0, CTL_ZERO_BYTES = 64 * 1024;
constexpr size_t WS_W_ATT_IN = 2 * MiB;
constexpr size_t WS_W_ATT_OUT = 7 * MiB;
constexpr size_t WS_W_DN_IN = 9 * MiB;
constexpr size_t WS_W_DN_OUT = 16 * MiB;
constexpr size_t WS_W_MEMKV = 18 * MiB;
constexpr size_t WS_W_GU = 20 * MiB;
constexpr size_t WS_W_DOWN = 42 * MiB;
constexpr size_t WS_MEMN = 54 * MiB;
constexpr size_t WS_MEMKV = 62 * MiB;
constexpr size_t WS_LSE = 66 * MiB;
constexpr size_t WS_GATE = 68 * MiB;
constexpr size_t WS_XN = 80 * MiB;
constexpr size_t WS_MIX = 144 * MiB;
constexpr size_t WS_Y = 208 * MiB;
constexpr size_t WS_BIG = 336 * MiB;
constexpr size_t WS_END = 512 * MiB;
constexpr int CW_BAR = 4096;

constexpr int RING_OFF = 0, RING_BYTES = 131072;
constexpr int LDSCTL_OFF = RING_BYTES, MISC_OFF = LDSCTL_OFF + 320;
constexpr int LDS_BYTES = 147456;

#define GAS __attribute__((address_space(1)))
#define LAS __attribute__((address_space(3)))
typedef unsigned short bf16;
typedef unsigned v4u __attribute__((ext_vector_type(4)));
typedef unsigned v2u __attribute__((ext_vector_type(2)));
typedef float f32x4 __attribute__((ext_vector_type(4)));
typedef GAS unsigned gu32;
#define RLX_AGENT __ATOMIC_RELAXED, __HIP_MEMORY_SCOPE_AGENT
#define LDS_WAIT() asm volatile("s_waitcnt lgkmcnt(0)" ::: "memory")
__device__ __forceinline__ unsigned f2bf(float f) { unsigned u = __builtin_bit_cast(unsigned, f); return (u + 0x7fffu + ((u >> 16) & 1u)) >> 16; }
__device__ __forceinline__ unsigned pk2(float lo, float hi) { return f2bf(lo) | (f2bf(hi) << 16); }
__device__ __forceinline__ float bf2f(unsigned b) { return __builtin_bit_cast(float, b << 16); }
__device__ __forceinline__ float bflo(unsigned w) { return __builtin_bit_cast(float, w << 16); }
__device__ __forceinline__ float bfhi(unsigned w) { return __builtin_bit_cast(float, w & 0xffff0000u); }
__device__ __forceinline__ float wave_sum(float v) {
#pragma unroll
    for (int o = 1; o < 64; o <<= 1) v += __shfl_xor(v, o);
    return v;
}
__device__ __forceinline__ float wave_max(float v) {
#pragma unroll
    for (int o = 1; o < 64; o <<= 1) v = fmaxf(v, __shfl_xor(v, o));
    return v;
}
__device__ __forceinline__ float silu(float x) { return x / (1.0f + __expf(-x)); }

#define XB_TMO      128
#define XB_XCNT(j)  (256  + 64 * (j))
#define XB_XSUB(j)  (1280 + 64 * (j))
#define XB_XGEN(j)  (2304 + 64 * (j))
#define XB_TOP      3328
#define XB_TOPGEN   3392
#define XCD_BAR_WORDS 3456
#define XB_SPIN_CAP (1u << 18)

__device__ __forceinline__ unsigned xb_ld(unsigned* p)              { return __hip_atomic_load(p, __ATOMIC_RELAXED, __HIP_MEMORY_SCOPE_AGENT); }
__device__ __forceinline__ unsigned xb_add(unsigned* p, unsigned v) { return __hip_atomic_fetch_add(p, v, __ATOMIC_RELAXED, __HIP_MEMORY_SCOPE_AGENT); }
__device__ __forceinline__ unsigned xb_xcc_id() { return (unsigned)__builtin_amdgcn_s_getreg((3 << 11) | 20) & 0xFu; }
#define XB_SPIN(cond, bar) do { unsigned _sp = 0; while (cond) { __builtin_amdgcn_s_sleep(1); \
    if ((++_sp & 255u) == 0u) { if (xb_ld(&(bar)[XB_TMO])) break; if (_sp > XB_SPIN_CAP) { atomicAdd(&(bar)[XB_TMO], 1u); break; } } } } while (0)

struct XcdBarrier {
    unsigned* bar; unsigned x;
    volatile LAS unsigned* st;
};

__device__ __forceinline__ XcdBarrier xcd_barrier_post(unsigned* bar, volatile LAS unsigned* st) {
    XcdBarrier b; b.bar = bar; b.x = xb_xcc_id(); b.st = st;
    if (threadIdx.x == 0) (void)xb_add(&bar[XB_XCNT(b.x)], 1u);
    return b;
}
__device__ __forceinline__ void xcd_barrier_complete(unsigned* bar, unsigned x, unsigned& nloc, unsigned& nx) {
    const unsigned G = gridDim.x * gridDim.y * gridDim.z;
    unsigned sum, cnt, mine, sp = 0u;
    for (;;) {
        sum = 0u; cnt = 0u; mine = 0u;
#pragma unroll
        for (unsigned j = 0; j < 16; ++j) { const unsigned c = xb_ld(&bar[XB_XCNT(j)]); sum += c; cnt += (c > 0u) ? 1u : 0u; mine = (j == x) ? c : mine; }
        if (sum == G) break;
        __builtin_amdgcn_s_sleep(1);
        if ((++sp & 255u) == 0u) { if (xb_ld(&bar[XB_TMO])) break; if (sp > XB_SPIN_CAP) { atomicAdd(&bar[XB_TMO], 1u); break; } }
    }
    nloc = mine > 0u ? mine : 1u; nx = cnt > 0u ? cnt : 1u;
}

__device__ __forceinline__ void xcd_barrier(const XcdBarrier& b) {
    asm volatile("s_waitcnt vmcnt(0)" ::: "memory");
    __syncthreads();
    if (threadIdx.x == 0) {
        unsigned* bar = b.bar;
        __builtin_amdgcn_s_waitcnt(0);
        unsigned nloc = b.st[0], nx = b.st[1];
        if (nloc == 0u) { xcd_barrier_complete(bar, b.x, nloc, nx); b.st[0] = nloc; b.st[1] = nx; }
        const unsigned old = xb_add(&bar[XB_XSUB(b.x)], 1u);
        const unsigned gen = old / nloc;
        if (old + 1u == (gen + 1u) * nloc) {
            __builtin_amdgcn_fence(__ATOMIC_RELEASE, "agent");
            asm volatile("s_waitcnt vmcnt(0)" ::: "memory");
            const unsigned og = xb_add(&bar[XB_TOP], 1u);
            const unsigned tg = og / nx;
            if (og + 1u == (tg + 1u) * nx) xb_add(&bar[XB_TOPGEN], 1u);
            else XB_SPIN(xb_ld(&bar[XB_TOPGEN]) == tg, bar);
            __builtin_amdgcn_fence(__ATOMIC_ACQUIRE, "agent");
            xb_add(&bar[XB_XGEN(b.x)], 1u);
            asm volatile("s_waitcnt vmcnt(0)" ::: "memory");
        } else {
            XB_SPIN(xb_ld(&bar[XB_XGEN(b.x)]) == gen, bar);
            __builtin_amdgcn_fence(__ATOMIC_ACQUIRE, "agent");
            asm volatile("s_waitcnt vmcnt(0)" ::: "memory");
        }
    }
    __syncthreads();
}


__device__ const unsigned char BUCKET[3][132] = {
{11,11,11,11,11,11,11,11,11,11,11,11,11,11,11,10,10,10,10,10,10,10,10,10,10,10,10,10,10,10,10,10,10,10,10,10,10,10,9,9,9,9,9,9,9,9,9,9,9,9,8,8,8,8,8,8,8,7,6,5,4,3,2,1,0,17,18,19,20,21,22,23,24,24,24,24,24,24,24,25,25,25,25,25,25,25,25,25,25,25,25,26,26,26,26,26,26,26,26,26,26,26,26,26,26,26,26,26,26,26,26,26,26,26,27,27,27,27,27,27,27,27,27,27,27,27,27,27,27,0,0,0},
{13,13,13,13,13,13,13,13,13,13,13,13,13,13,13,13,13,13,13,13,13,13,13,12,12,12,12,12,12,12,12,12,12,12,12,12,12,12,12,12,12,12,11,11,11,11,11,11,11,11,11,11,10,10,10,10,10,10,9,9,9,8,8,4,0,20,24,24,25,25,25,26,26,26,26,26,26,27,27,27,27,27,27,27,27,27,27,28,28,28,28,28,28,28,28,28,28,28,28,28,28,28,28,28,28,28,29,29,29,29,29,29,29,29,29,29,29,29,29,29,29,29,29,29,29,29,29,29,29,0,0,0},
{15,15,15,15,15,15,15,15,15,15,15,15,15,15,15,15,15,15,15,15,15,15,15,15,15,15,15,15,15,15,14,14,14,14,14,14,14,14,14,14,14,14,14,14,14,13,13,13,13,13,13,13,13,13,12,12,12,12,12,11,11,10,10,9,0,25,26,26,27,27,28,28,28,28,28,29,29,29,29,29,29,29,29,29,30,30,30,30,30,30,30,30,30,30,30,30,30,30,30,31,31,31,31,31,31,31,31,31,31,31,31,31,31,31,31,31,31,31,31,31,31,31,31,31,31,31,31,31,31,0,0,0}};

struct Frame {
    LAS unsigned char* lds;
    unsigned char* ldsg;
    volatile LAS unsigned* MISC;
    gu32* ctl;
    int tid, lane, wave;
    int vcu, G, bx;
    float* out; unsigned char* ws;
};
#define WSP(F, type, off) ((type*)((F).ws + (off)))
template <int I> __device__ __forceinline__ const float* arg_in() {
    const auto kp = __builtin_amdgcn_kernarg_segment_ptr(); unsigned long long p;
    asm volatile("s_load_dwordx2 %0, %1, %2\n\ts_waitcnt lgkmcnt(0)" : "=s"(p) : "s"(kp), "n"(I * 8));
    return (const float*)p;
}
#define ARG_IN(i) (arg_in<i>())

__device__ __forceinline__ int src_col(int kind, int n) {
    if (kind == 1) { if (n < 3072) return n; if (n < 3328) return 3096 + (n - 3072); if (n < 3352) return 3072 + (n - 3328); return -1; }
    if (kind == 2) { const int t = n >> 8, h = (n >> 7) & 1, c = n & 127; return h * DFF + 128 * t + c; }
    return n;
}
__device__ __forceinline__ void transpose_w(Frame& F, const float* W, int K, int Nsrc, bf16* WT, int Ndst, int kind) {
    float* scr = (float*)(F.ldsg + F.wave * 16384);
    const int gw = F.vcu * NWAVES + F.wave, NGW = F.G * NWAVES, lane = F.lane;
    const int nblk = Ndst / 32, nitems = (K / 64) * nblk;
    for (int it = gw; it < nitems; it += NGW) {
        const int kb = it / nblk, nb = it % nblk, k0 = 64 * kb, n0 = 32 * nb;
        const int sc = src_col(kind, n0 + (lane & 31));
#pragma unroll 8
        for (int i = 0; i < 32; ++i) { const int kk = 2 * i + (lane >> 5); scr[kk * 33 + (lane & 31)] = sc >= 0 ? W[(size_t)(k0 + kk) * Nsrc + sc] : 0.f; }
        LDS_WAIT(); asm volatile("" ::: "memory");
        const int c = lane & 7;
#pragma unroll
        for (int j = 0; j < 4; ++j) { const int n = (lane >> 3) + 8 * j; const float* s = scr + (8 * c) * 33 + n;
            v4u o; o.x = pk2(s[0 * 33], s[1 * 33]); o.y = pk2(s[2 * 33], s[3 * 33]); o.z = pk2(s[4 * 33], s[5 * 33]); o.w = pk2(s[6 * 33], s[7 * 33]);
            *(v4u*)(WT + (size_t)(n0 + n) * K + k0 + 8 * c) = o; }
        LDS_WAIT(); asm volatile("" ::: "memory");
    }
}
__device__ __forceinline__ void rms_rows_bf16(Frame& F, const float* src, const float* gain, bf16* dst, int nrows) {
    const int gw = F.vcu * NWAVES + F.wave, NGW = F.G * NWAVES, lane = F.lane;
    for (int m = gw; m < nrows; m += NGW) {
        const f32x4* xr = (const f32x4*)(src + (size_t)m * D) + lane; const f32x4* gr = (const f32x4*)gain + lane;
        f32x4 v[4]; float s = 0.f;
#pragma unroll
        for (int j = 0; j < 4; ++j) { v[j] = xr[64 * j]; s += (v[j].x * v[j].x + v[j].y * v[j].y) + (v[j].z * v[j].z + v[j].w * v[j].w); }
        const float r = 1.0f / sqrtf(wave_sum(s) * (1.f / D) + EPS);
        v2u* o8 = (v2u*)(dst + (size_t)m * D) + lane;
#pragma unroll
        for (int j = 0; j < 4; ++j) { const f32x4 g = gr[64 * j]; v2u w; w.x = pk2(v[j].x * r * g.x, v[j].y * r * g.y); w.y = pk2(v[j].z * r * g.z, v[j].w * r * g.w); o8[64 * j] = w; }
    }
}
__device__ __forceinline__ void row_pass(Frame& F, const float* xold, const float* Y, const float* g_post, float* xnew, const float* g_pre, bf16* xn) {
    const int gw = F.vcu * NWAVES + F.wave, NGW = F.G * NWAVES, lane = F.lane;
    for (int m = gw; m < T; m += NGW) {
        const f32x4* yr = (const f32x4*)(Y + (size_t)m * D) + lane; const f32x4* xr = (const f32x4*)(xold + (size_t)m * D) + lane;
        f32x4 y[4], x[4]; float s = 0.f;
#pragma unroll
        for (int j = 0; j < 4; ++j) { y[j] = yr[64 * j]; x[j] = xr[64 * j]; s += (y[j].x * y[j].x + y[j].y * y[j].y) + (y[j].z * y[j].z + y[j].w * y[j].w); }
        const float r = 1.0f / sqrtf(wave_sum(s) * (1.f / D) + EPS);
        f32x4* xo = (f32x4*)(xnew + (size_t)m * D) + lane; float s2 = 0.f;
#pragma unroll
        for (int j = 0; j < 4; ++j) { const f32x4 g = ((const f32x4*)g_post + lane)[64 * j]; x[j] = x[j] + y[j] * r * g; xo[64 * j] = x[j];
            s2 += (x[j].x * x[j].x + x[j].y * x[j].y) + (x[j].z * x[j].z + x[j].w * x[j].w); }
        if (g_pre) {
            const float r2 = 1.0f / sqrtf(wave_sum(s2) * (1.f / D) + EPS);
            v2u* o8 = (v2u*)(xn + (size_t)m * D) + lane;
#pragma unroll
            for (int j = 0; j < 4; ++j) { const f32x4 g = ((const f32x4*)g_pre + lane)[64 * j]; v2u w; w.x = pk2(x[j].x * r2 * g.x, x[j].y * r2 * g.y); w.y = pk2(x[j].z * r2 * g.z, x[j].w * r2 * g.w); o8[64 * j] = w; }
        }
    }
}

__device__ __forceinline__ void attn_band_naive(Frame& F) {
    const int gw = F.vcu * NWAVES + F.wave, NGW = F.G * NWAVES, lane = F.lane;
    const bf16* PR = WSP(F, const bf16, WS_BIG); bf16* MIX = WSP(F, bf16, WS_MIX); float* LSE = WSP(F, float, WS_LSE);
    const float* rel_bias = ARG_IN(2);
    for (int task = gw; task < T * NHEAD_A; task += NGW) {
        const int t = task / NHEAD_A, head = task % NHEAD_A, g = head >> 2, dil = 1 << (2 * g), b = t >> 12, s = t & (SEQ - 1);
        const float qv = bf2f(PR[(size_t)t * ATT_IN + head * 64 + lane]);
        float lg[3]; bool val[3];
#pragma unroll
        for (int pass = 0; pass < 3; ++pass) {
            const int ji = lane + 64 * pass, pos = s + (ji - 64) * dil; const bool valid = (ji <= 128) && pos >= 0 && pos < SEQ;
            const bf16* krow = PR + (size_t)(b * SEQ + (valid ? pos : s)) * ATT_IN + TOKW + head * 64;
            float dot = 0.f;
#pragma unroll
            for (int d8 = 0; d8 < 8; ++d8) { const v4u kk = *(const v4u*)(krow + 8 * d8);
                dot += bflo(kk.x) * __shfl(qv, 8 * d8 + 0) + bfhi(kk.x) * __shfl(qv, 8 * d8 + 1) + bflo(kk.y) * __shfl(qv, 8 * d8 + 2) + bfhi(kk.y) * __shfl(qv, 8 * d8 + 3)
                     + bflo(kk.z) * __shfl(qv, 8 * d8 + 4) + bfhi(kk.z) * __shfl(qv, 8 * d8 + 5) + bflo(kk.w) * __shfl(qv, 8 * d8 + 6) + bfhi(kk.w) * __shfl(qv, 8 * d8 + 7); }
            const int jc = ji <= 128 ? ji : 128;
            lg[pass] = valid ? dot * 0.125f + rel_bias[(int)BUCKET[g][jc] * NHEAD_A + head] : -1e30f; val[pass] = valid;
        }
        const float mx = wave_max(fmaxf(fmaxf(lg[0], lg[1]), lg[2]));
        float p[3];
#pragma unroll
        for (int pass = 0; pass < 3; ++pass) p[pass] = val[pass] ? __expf(lg[pass] - mx) : 0.f;
        const float den = wave_sum(p[0] + p[1] + p[2]);
        float o = 0.f;
        const bf16* vbase = PR + (size_t)(b * SEQ) * ATT_IN + 2 * TOKW + head * 64 + lane;
        for (int ji = 0; ji < 129; ++ji) {
            const int pos = s + (ji - 64) * dil; if (pos < 0 || pos >= SEQ) continue;
            const float pj = __shfl(ji < 64 ? p[0] : (ji < 128 ? p[1] : p[2]), ji & 63);
            o += pj * bf2f(vbase[(size_t)pos * ATT_IN]);
        }
        MIX[(size_t)t * D + head * 64 + lane] = (bf16)f2bf(o / den);
        if (lane == 0) LSE[(size_t)t * NHEAD_A + head] = mx + __logf(den);
    }
}
__device__ __forceinline__ void attn_mem_naive(Frame& F, const bf16* qsrc, int qpitch, const bf16* KV, int vb, int nvb) {
    const int gw = vb * NWAVES + F.wave, NGW = nvb * NWAVES, lane = F.lane;
    bf16* MIX = WSP(F, bf16, WS_MIX);
    for (int task = gw; task < T * 4; task += NGW) {
        const int t = task >> 2, mh = task & 3, b = t >> 12;
        const float qv = bf2f(qsrc[(size_t)t * qpitch + mh * 64 + lane]);
        float lg[4];
#pragma unroll
        for (int pass = 0; pass < 4; ++pass) {
            const bf16* krow = KV + (size_t)(b * MEML + lane + 64 * pass) * 512 + mh * 64;
            float dot = 0.f;
#pragma unroll
            for (int d8 = 0; d8 < 8; ++d8) { const v4u kk = *(const v4u*)(krow + 8 * d8);
                dot += bflo(kk.x) * __shfl(qv, 8 * d8 + 0) + bfhi(kk.x) * __shfl(qv, 8 * d8 + 1) + bflo(kk.y) * __shfl(qv, 8 * d8 + 2) + bfhi(kk.y) * __shfl(qv, 8 * d8 + 3)
                     + bflo(kk.z) * __shfl(qv, 8 * d8 + 4) + bfhi(kk.z) * __shfl(qv, 8 * d8 + 5) + bflo(kk.w) * __shfl(qv, 8 * d8 + 6) + bfhi(kk.w) * __shfl(qv, 8 * d8 + 7); }
            lg[pass] = dot * 0.125f;
        }
        const float mx = wave_max(fmaxf(fmaxf(lg[0], lg[1]), fmaxf(lg[2], lg[3])));
        float p[4];
#pragma unroll
        for (int pass = 0; pass < 4; ++pass) p[pass] = __expf(lg[pass] - mx);
        const float den = wave_sum((p[0] + p[1]) + (p[2] + p[3]));
        float o = 0.f;
        const bf16* vbase = KV + (size_t)(b * MEML) * 512 + 256 + mh * 64 + lane;
        for (int m = 0; m < MEML; ++m) {
            const float pj = __shfl(m < 64 ? p[0] : (m < 128 ? p[1] : (m < 192 ? p[2] : p[3])), m & 63);
            o += pj * bf2f(vbase[(size_t)m * 512]);
        }
        MIX[(size_t)t * D + TOKW + mh * 64 + lane] = (bf16)f2bf(o / den);
    }
}
typedef short bf16x8v __attribute__((ext_vector_type(8)));
typedef short s4v __attribute__((ext_vector_type(4)));
constexpr int AT_STRIDE = 160;
constexpr int AT_K = 0, AT_V = 256 * AT_STRIDE, AT_BIAS = 2 * 256 * AT_STRIDE;
struct AttnUnit {
    const bf16* qsrc; int qpitch, qcol, tbase, tstep;
    const bf16* ksrc; int kpitch, kcol, vcol, kbase, kstep, koff, kmax;
    int ocol, head, grp, L, m0;
};
template <int NT, bool BAND>
__device__ __forceinline__ void attn_unit_fast(Frame& F, const AttnUnit& U) {
    const int tid = F.tid, lane = F.lane, w = F.wave, q = lane & 15, g = lane >> 4;
    LAS unsigned char* Kl = F.lds + AT_K; LAS unsigned char* Vl = F.lds + AT_V; LAS float* bias = (LAS float*)(F.lds + AT_BIAS);
    bf16* MIX = WSP(F, bf16, WS_MIX);
    __syncthreads();
    {
        v4u kv[4], vv[4];
#pragma unroll
        for (int i = 0; i < 4; ++i) { const int row = (tid >> 3) + 64 * i; int kr = row + U.koff; kr = kr < 0 ? 0 : (kr > U.kmax ? U.kmax : kr);
            const bf16* p = U.ksrc + (size_t)(U.kbase + kr * U.kstep) * U.kpitch + (tid & 7) * 8;
            kv[i] = *(const v4u*)(p + U.kcol); vv[i] = *(const v4u*)(p + U.vcol); }
#pragma unroll
        for (int i = 0; i < 4; ++i) { const int off = ((tid >> 3) + 64 * i) * AT_STRIDE + (tid & 7) * 16;
            *(LAS v4u*)(Kl + off) = kv[i]; *(LAS v4u*)(Vl + off) = vv[i]; }
        if (BAND && tid < 129) bias[tid] = ARG_IN(2)[(int)BUCKET[U.grp][tid] * NHEAD_A + U.head];
    }
    const int tok = U.tbase + (16 * w + q) * U.tstep;
    bf16x8v qf[2];
#pragma unroll
    for (int kk = 0; kk < 2; ++kk) qf[kk] = *(const bf16x8v*)(U.qsrc + (size_t)tok * U.qpitch + U.qcol + 32 * kk + 8 * g);
    __syncthreads();
    const int tb = BAND ? w : 0;
    f32x4 s[NT];
#pragma unroll
    for (int t = 0; t < NT; ++t) { s[t] = (f32x4){0.f, 0.f, 0.f, 0.f};
#pragma unroll
        for (int kk = 0; kk < 2; ++kk) { const bf16x8v a = *(const LAS bf16x8v*)(Kl + (16 * (tb + t) + q) * AT_STRIDE + (32 * kk + 8 * g) * 2);
            s[t] = __builtin_amdgcn_mfma_f32_16x16x32_bf16(a, qf[kk], s[t], 0, 0, 0); } }
    float mx = -3.0e38f;
#pragma unroll
    for (int t = 0; t < NT; ++t)
#pragma unroll
        for (int r = 0; r < 4; ++r) { float v = s[t][r] * 0.125f;
            if (BAND) { const int kl = 16 * t + 4 * g + r, ji = kl - q, m = U.m0 + 16 * w - 64 + kl; const bool ok = ji >= 0 && ji <= 128 && m >= 0 && m < U.L;
                v = ok ? v + bias[ji < 0 ? 0 : (ji > 128 ? 128 : ji)] : -1.0e30f; }
            s[t][r] = v; mx = fmaxf(mx, v); }
    mx = fmaxf(mx, __shfl_xor(mx, 16)); mx = fmaxf(mx, __shfl_xor(mx, 32));
    float den = 0.f;
#pragma unroll
    for (int t = 0; t < NT; ++t)
#pragma unroll
        for (int r = 0; r < 4; ++r) { const float p = __expf(s[t][r] - mx); s[t][r] = p; den += p; }
    den += __shfl_xor(den, 16); den += __shfl_xor(den, 32);
    f32x4 o[4];
#pragma unroll
    for (int dt = 0; dt < 4; ++dt) o[dt] = (f32x4){0.f, 0.f, 0.f, 0.f};
    constexpr int NKB = (NT + 1) / 2;
#pragma unroll
    for (int kb = 0; kb < NKB; ++kb) {
        const int ta = 2 * kb, tc = 2 * kb + 1; const bool has_c = tc < NT;
        const f32x4 pa = s[ta], pc = has_c ? s[tc < NT ? tc : 0] : (f32x4){0.f, 0.f, 0.f, 0.f};
        v4u pw; pw.x = pk2(pa[0], pa[1]); pw.y = pk2(pa[2], pa[3]); pw.z = pk2(pc[0], pc[1]); pw.w = pk2(pc[2], pc[3]);
        const bf16x8v pf = __builtin_bit_cast(bf16x8v, pw);
        int tia = tb + ta, tic = tb + tc; tic = tic > 15 ? 15 : tic;
        LAS unsigned char* ra = Vl + (16 * tia + 4 * g + (q >> 2)) * AT_STRIDE + 8 * (q & 3);
        LAS unsigned char* rc = Vl + (16 * tic + 4 * g + (q >> 2)) * AT_STRIDE + 8 * (q & 3);
#pragma unroll
        for (int dt = 0; dt < 4; ++dt) {
            const s4v va = __builtin_amdgcn_ds_read_tr16_b64_v4i16((LAS s4v*)(ra + 32 * dt)), vc = __builtin_amdgcn_ds_read_tr16_b64_v4i16((LAS s4v*)(rc + 32 * dt));
            bf16x8v af; af[0] = va[0]; af[1] = va[1]; af[2] = va[2]; af[3] = va[3]; af[4] = vc[0]; af[5] = vc[1]; af[6] = vc[2]; af[7] = vc[3];
            o[dt] = __builtin_amdgcn_mfma_f32_16x16x32_bf16(af, pf, o[dt], 0, 0, 0);
        }
    }
    const float inv = 1.0f / den;
    bf16* orow = MIX + (size_t)tok * D + U.ocol + 4 * g;
#pragma unroll
    for (int dt = 0; dt < 4; ++dt) { v2u wv; wv.x = pk2(o[dt][0] * inv, o[dt][1] * inv); wv.y = pk2(o[dt][2] * inv, o[dt][3] * inv); *(v2u*)(orow + 16 * dt) = wv; }
    if (BAND && g == 0) WSP(F, float, WS_LSE)[(size_t)tok * NHEAD_A + U.head] = mx + __logf(den);
}
__device__ __forceinline__ void attn_phase_fast(Frame& F, bool mem_only, int vb, int nvb) {
    const bf16* PR = WSP(F, const bf16, WS_BIG); const bf16* MIXc = WSP(F, const bf16, WS_MIX);
    const int nband = mem_only ? 0 : NB * NHEAD_A * 32, ntot = nband + NB * 4 * 32;
#pragma unroll 1
    for (int u = vb; u < ntot; u += nvb) {
        AttnUnit U;
        if (u < nband) {
            const int blk = u & 31, head = (u >> 5) % NHEAD_A, b = u / (32 * NHEAD_A), grp = head >> 2, dil = 1 << (2 * grp), L = SEQ / dil, bpc = L / 128, r = blk / bpc, m0 = (blk % bpc) * 128;
            U.qsrc = PR; U.qpitch = ATT_IN; U.qcol = head * 64; U.tbase = b * SEQ + r + dil * m0; U.tstep = dil;
            U.ksrc = PR; U.kpitch = ATT_IN; U.kcol = TOKW + head * 64; U.vcol = 2 * TOKW + head * 64; U.kbase = b * SEQ + r; U.kstep = dil; U.koff = m0 - 64; U.kmax = L - 1;
            U.ocol = head * 64; U.head = head; U.grp = grp; U.L = L; U.m0 = m0;
            attn_unit_fast<9, true>(F, U);
        } else {
            const int v = u - nband, blk = v & 31, mh = (v >> 5) & 3, b = v >> 7;
            U.qsrc = mem_only ? MIXc : PR; U.qpitch = mem_only ? D : ATT_IN; U.qcol = (mem_only ? TOKW : 3 * TOKW) + mh * 64; U.tbase = b * SEQ + blk * 128; U.tstep = 1;
            U.ksrc = WSP(F, const bf16, WS_MEMKV) + (mem_only ? (size_t)NB * MEML * 512 : 0); U.kpitch = 512; U.kcol = mh * 64; U.vcol = 256 + mh * 64; U.kbase = b * MEML; U.kstep = 1; U.koff = 0; U.kmax = MEML - 1;
            U.ocol = TOKW + mh * 64; U.head = 0; U.grp = 0; U.L = MEML; U.m0 = 0;
            attn_unit_fast<16, false>(F, U);
        }
    }
}

__device__ __forceinline__ void lse_mix(Frame& F) {
    const int gw = F.vcu * NWAVES + F.wave, NGW = F.G * NWAVES, lane = F.lane;
    bf16* MIX = WSP(F, bf16, WS_MIX); const float* LSE = WSP(F, const float, WS_LSE);
    for (int t = gw; t < T; t += NGW) {
        float w[12];
#pragma unroll
        for (int j = 0; j < 4; ++j) { const float l0 = LSE[(size_t)t * 12 + j], l1 = LSE[(size_t)t * 12 + 4 + j], l2 = LSE[(size_t)t * 12 + 8 + j];
            const float mx = fmaxf(l0, fmaxf(l1, l2)); const float e0 = __expf(l0 - mx), e1 = __expf(l1 - mx), e2 = __expf(l2 - mx), inv = 1.0f / (e0 + e1 + e2);
            w[j] = e0 * inv; w[4 + j] = e1 * inv; w[8 + j] = e2 * inv; }
        bf16* row = MIX + (size_t)t * D + lane;
#pragma unroll
        for (int h = 0; h < 12; ++h) row[64 * h] = (bf16)f2bf(bf2f(row[64 * h]) * w[h]);
    }
}

__device__ __forceinline__ void dn_naive(Frame& F, int chain) {
    const int b = chain / 12, h = (chain >> 1) % 6, dir = chain & 1, tid = F.tid, lane = F.lane, wave = F.wave;
    const bf16* P = WSP(F, const bf16, WS_BIG); const float* GATE = WSP(F, const float, WS_GATE); float* O = WSP(F, float, WS_Y);
    const float* conv_w = ARG_IN(6); const float a_neg = -__expf(ARG_IN(7)[dir * 6 + h]); const float dtb = ARG_IN(8)[dir * 6 + h];
    float* qs = (float*)F.ldsg; float* ks = qs + 64 * 128; float* vs = ks + 64 * 128; float* gl = vs + 64 * 128; float* bl = gl + 64;
    float S[128];
#pragma unroll
    for (int i = 0; i < 128; ++i) S[i] = 0.f;
    for (int cc = 0; cc < NCHUNK; ++cc) {
        const int c = dir ? (NCHUNK - 1 - cc) : cc; const int s0 = c * CH; const size_t t0 = (size_t)b * SEQ + s0;
        __syncthreads();
        for (int idx = tid; idx < 64 * 384; idx += NWAVES * 64) {
            const int tok = idx / 384, ch = idx % 384, which = ch >> 7, d = ch & 127, col = which * TOKW + h * DNH + d;
            float acc = 0.f;
#pragma unroll
            for (int k = 0; k < 5; ++k) { const int s = s0 + tok + k - 2; if (s >= 0 && s < SEQ) acc += bf2f(P[((size_t)b * SEQ + s) * 2304 + col]) * conv_w[k * 2304 + col]; }
            qs[which * 8192 + tok * 128 + d] = silu(acc);
        }
        if (tid < 64) { const size_t t = t0 + tid; const float gi = GATE[t * 24 + dir * 12 + h] + dtb, bi = GATE[t * 24 + dir * 12 + 6 + h];
            const float sp = gi > 20.f ? gi : log1pf(__expf(gi)); gl[tid] = a_neg * sp; bl[tid] = 1.0f / (1.0f + __expf(-bi)); }
        __syncthreads();
#pragma unroll 1
        for (int i = 0; i < 8; ++i) { const int tok = wave * 8 + i;
            const float q0 = qs[tok * 128 + lane], q1 = qs[tok * 128 + 64 + lane], k0 = ks[tok * 128 + lane], k1 = ks[tok * 128 + 64 + lane];
            const float rq = 0.08838834764831845f / sqrtf(wave_sum(q0 * q0 + q1 * q1) + EPS), rk = 1.0f / sqrtf(wave_sum(k0 * k0 + k1 * k1) + EPS);
            qs[tok * 128 + lane] = q0 * rq; qs[tok * 128 + 64 + lane] = q1 * rq; ks[tok * 128 + lane] = k0 * rk; ks[tok * 128 + 64 + lane] = k1 * rk; }
        __syncthreads();
        if (tid < 128) {
            const int j = tid;
#pragma unroll 1
            for (int i = 0; i < CH; ++i) {
                const int p = dir ? (CH - 1 - i) : i;
                const float eg = __expf(gl[p]), bt = bl[p], vj = vs[p * 128 + j];
                const f32x4* kp = (const f32x4*)(ks + p * 128); const f32x4* qp = (const f32x4*)(qs + p * 128);
                float r0 = 0.f, r1 = 0.f, r2 = 0.f, r3 = 0.f;
#pragma unroll
                for (int i4 = 0; i4 < 32; ++i4) { const f32x4 kv = kp[i4]; r0 += kv.x * S[4 * i4]; r1 += kv.y * S[4 * i4 + 1]; r2 += kv.z * S[4 * i4 + 2]; r3 += kv.w * S[4 * i4 + 3]; if ((i4 & 3) == 3) asm volatile("" ::: "memory"); }
                const float r = (r0 + r1) + (r2 + r3);
                const float c1 = bt * (vj - eg * r);
                float o0 = 0.f, o1 = 0.f, o2 = 0.f, o3 = 0.f;
#pragma unroll
                for (int i4 = 0; i4 < 32; ++i4) { const f32x4 kv = kp[i4], qv = qp[i4];
                    S[4 * i4] = eg * S[4 * i4] + kv.x * c1; S[4 * i4 + 1] = eg * S[4 * i4 + 1] + kv.y * c1; S[4 * i4 + 2] = eg * S[4 * i4 + 2] + kv.z * c1; S[4 * i4 + 3] = eg * S[4 * i4 + 3] + kv.w * c1;
                    o0 += qv.x * S[4 * i4]; o1 += qv.y * S[4 * i4 + 1]; o2 += qv.z * S[4 * i4 + 2]; o3 += qv.w * S[4 * i4 + 3]; if ((i4 & 3) == 3) asm volatile("" ::: "memory"); }
                atomicAdd(O + (t0 + p) * TOKW + h * DNH + j, (o0 + o1) + (o2 + o3));
            }
        }
    }
}
constexpr size_t WS_TB = WS_XN;
constexpr size_t WS_OF = WS_Y, WS_OB = WS_Y + (size_t)T * TOKW * 2;
constexpr int DQ = 0, DQ_S = 272, DK = 17408, DK_S = 288, DV = 35840, DV_S = 288, DW = 54272, DW_S = 272, DI = 71680, DI_S = 144, DG = 80896;
constexpr int DA_KK = 36864, DA_L = 53760, DA_G = 86528;
__device__ __forceinline__ bf16x8v mk_frag(v2u lo, v2u hi) { v4u w; w.x = lo.x; w.y = lo.y; w.z = hi.x; w.w = hi.y; return __builtin_bit_cast(bf16x8v, w); }
__device__ __forceinline__ bf16x8v frag_k2(LAS unsigned char* base, int row, int stride, int cb, int g) {
    LAS unsigned char* p = base + row * stride + (cb + 4 * g) * 2; return mk_frag(*(LAS v2u*)p, *(LAS v2u*)(p + 32)); }
__device__ __forceinline__ bf16x8v frag_tr(LAS unsigned char* base, int stride, int rb, int col0, int i, int g) {
    LAS unsigned char* p = base + (rb + 4 * g + (i >> 2)) * stride + (col0 + 4 * (i & 3)) * 2;
    const s4v a = __builtin_amdgcn_ds_read_tr16_b64_v4i16((LAS s4v*)p), c = __builtin_amdgcn_ds_read_tr16_b64_v4i16((LAS s4v*)(p + 16 * stride));
    bf16x8v f; f[0] = a[0]; f[1] = a[1]; f[2] = a[2]; f[3] = a[3]; f[4] = c[0]; f[5] = c[1]; f[6] = c[2]; f[7] = c[3]; return f; }
__device__ __forceinline__ bf16x8v frag_acc(f32x4 a, f32x4 c) { v4u w; w.x = pk2(a[0], a[1]); w.y = pk2(a[2], a[3]); w.z = pk2(c[0], c[1]); w.w = pk2(c[2], c[3]); return __builtin_bit_cast(bf16x8v, w); }
__device__ __forceinline__ bf16x8v scale_frag(v4u raw, f32x4 slo, f32x4 shi) { v4u w;
    w.x = pk2(bflo(raw.x) * slo[0], bfhi(raw.x) * slo[1]); w.y = pk2(bflo(raw.y) * slo[2], bfhi(raw.y) * slo[3]);
    w.z = pk2(bflo(raw.z) * shi[0], bfhi(raw.z) * shi[1]); w.w = pk2(bflo(raw.w) * shi[2], bfhi(raw.w) * shi[3]); return __builtin_bit_cast(bf16x8v, w); }
__device__ __forceinline__ void conv4x4(const bf16* P, const float* cw, int b, int s, int col0, float (&out)[4][4]) {
    float x[8][4];
#pragma unroll
    for (int rr = 0; rr < 8; ++rr) { const int sr = s - 2 + rr; v2u w = (v2u){0u, 0u};
        if (sr >= 0 && sr < SEQ) w = *(const v2u*)(P + ((size_t)b * SEQ + sr) * 2304 + col0);
        x[rr][0] = bflo(w.x); x[rr][1] = bfhi(w.x); x[rr][2] = bflo(w.y); x[rr][3] = bfhi(w.y); }
    f32x4 c[5];
#pragma unroll
    for (int k = 0; k < 5; ++k) c[k] = *(const f32x4*)(cw + k * 2304 + col0);
#pragma unroll
    for (int tt = 0; tt < 4; ++tt)
#pragma unroll
        for (int e = 0; e < 4; ++e) { float a = 0.f;
#pragma unroll
            for (int k = 0; k < 5; ++k) a += x[tt + k][e] * c[k][e];
            out[tt][e] = silu(a); }
}
__device__ __forceinline__ float hw_sum32(float v) { v += __shfl_xor(v, 1); v += __shfl_xor(v, 2); v += __shfl_xor(v, 4); v += __shfl_xor(v, 8); v += __shfl_xor(v, 16); return v; }
__device__ __forceinline__ void dn_gates(Frame& F, int b, int h, int c, int dir, int lane, float& beta, float& cs) {
    const float* GATE = WSP(F, const float, WS_GATE);
    const size_t t = (size_t)b * SEQ + c * CH + lane;
    const float gi = GATE[t * 24 + dir * 12 + h] + ARG_IN(8)[dir * 6 + h], bi = GATE[t * 24 + dir * 12 + 6 + h];
    const float sp = gi > 20.f ? gi : log1pf(__expf(gi));
    cs = -__expf(ARG_IN(7)[dir * 6 + h]) * sp; beta = 1.0f / (1.0f + __expf(-bi));
#pragma unroll
    for (int o = 1; o < 64; o <<= 1) { const float up = __shfl_up(cs, o), dn = __shfl_down(cs, o); if (dir == 0) { if (lane >= o) cs += up; } else { if (lane + o < 64) cs += dn; } }
}
__device__ __forceinline__ void dn_tsolve_unit(Frame& F, int unit) {
    const int c = unit & 63, h = (unit >> 6) % NHEAD_D, b = unit / (64 * NHEAD_D);
    int tid_ = F.tid; asm volatile("" : "+v"(tid_));
    const int tid = tid_, lane = tid & 63, w = F.wave, i = lane & 15, g = lane >> 4;
    const bf16* P = WSP(F, const bf16, WS_BIG); bf16* TB = WSP(F, bf16, WS_TB);
    LAS unsigned char* Kl = F.lds + DK; LAS float* KK = (LAS float*)(F.lds + DA_KK); LAS float* Ll = (LAS float*)(F.lds + DA_L); LAS float* Gl = (LAS float*)(F.lds + DA_G);
    __syncthreads();
    {   const int hw = 2 * w + (lane >> 5), cg = lane & 31; float o[4][4];
        conv4x4(P, ARG_IN(6), b, c * CH + 4 * hw, TOKW + h * DNH + 4 * cg, o);
#pragma unroll
        for (int tt = 0; tt < 4; ++tt) { const float r = 1.0f / sqrtf(hw_sum32((o[tt][0] * o[tt][0] + o[tt][1] * o[tt][1]) + (o[tt][2] * o[tt][2] + o[tt][3] * o[tt][3])) + EPS);
            v2u wv; wv.x = pk2(o[tt][0] * r, o[tt][1] * r); wv.y = pk2(o[tt][2] * r, o[tt][3] * r); *(LAS v2u*)(Kl + (4 * hw + tt) * DK_S + 8 * cg) = wv; }
    }
    if (w < 2) { float beta, cs; dn_gates(F, b, h, c, w, lane, beta, cs); Gl[w * 64 + lane] = cs; Gl[128 + w * 64 + lane] = beta; }
    __syncthreads();
#pragma unroll
    for (int tt = 0; tt < 2; ++tt) { const int id = 2 * w + tt, it = id >> 2, jt = id & 3; f32x4 acc = (f32x4){0.f, 0.f, 0.f, 0.f};
#pragma unroll
        for (int ks = 0; ks < 4; ++ks) { const bf16x8v a = *(const LAS bf16x8v*)(Kl + (16 * it + i) * DK_S + (32 * ks + 8 * g) * 2), bb = *(const LAS bf16x8v*)(Kl + (16 * jt + i) * DK_S + (32 * ks + 8 * g) * 2);
            acc = __builtin_amdgcn_mfma_f32_16x16x32_bf16(a, bb, acc, 0, 0, 0); }
#pragma unroll
        for (int r = 0; r < 4; ++r) KK[(16 * it + 4 * g + r) * 65 + 16 * jt + i] = acc[r]; }
    __syncthreads();
    {   const int dir = tid >> 8, ii = (tid >> 2) & 63, j0 = (tid & 3) * 16, pi = dir ? 63 - ii : ii; const float gci = Gl[dir * 64 + pi], bi = Gl[128 + dir * 64 + pi];
#pragma unroll 2
        for (int jj = 0; jj < 16; ++jj) { const int j = j0 + jj, pj = dir ? 63 - j : j;
            Ll[(dir * 64 + ii) * 64 + j] = (j < ii) ? bi * KK[pi * 65 + pj] * __expf(gci - Gl[dir * 64 + pj]) : 0.f; } }
    __syncthreads();
    if (w < 2) {
        const int dir = w; float Tc[64];
#pragma unroll
        for (int ii = 0; ii < 64; ++ii) { float a0 = (lane == ii) ? 1.f : 0.f, a1 = 0.f;
#pragma unroll
            for (int j4 = 0; j4 < (ii + 3) / 4; ++j4) { const f32x4 l = *(const LAS f32x4*)(Ll + (dir * 64 + ii) * 64 + 4 * j4);
                if (4 * j4 + 0 < ii) a0 -= l[0] * Tc[4 * j4 + 0]; if (4 * j4 + 1 < ii) a1 -= l[1] * Tc[4 * j4 + 1];
                if (4 * j4 + 2 < ii) a0 -= l[2] * Tc[4 * j4 + 2]; if (4 * j4 + 3 < ii) a1 -= l[3] * Tc[4 * j4 + 3]; }
            Tc[ii] = a0 + a1; }
        bf16* TBp = TB + ((size_t)unit * 2 + dir) * 4096; const int pc = dir ? 63 - lane : lane;
#pragma unroll
        for (int ii = 0; ii < 64; ++ii) TBp[(dir ? 63 - ii : ii) * 64 + pc] = (bf16)f2bf(Tc[ii]);
    }
}
__device__ __forceinline__ void dn_scan(Frame& F, int chain) {
    const int b = chain / 12, h = (chain >> 1) % NHEAD_D, dir = chain & 1;
    const int lane = F.lane, w = F.wave, i = lane & 15, g = lane >> 4;
    const bf16* P = WSP(F, const bf16, WS_BIG); const bf16* TB = WSP(F, const bf16, WS_TB); bf16* OD = WSP(F, bf16, dir ? WS_OB : WS_OF);
    LAS unsigned char* Ql = F.lds + DQ; LAS unsigned char* Kl = F.lds + DK; LAS unsigned char* Vl = F.lds + DV; LAS unsigned char* Wl = F.lds + DW; LAS unsigned char* Il = F.lds + DI;
    LAS float* Gl = (LAS float*)(F.lds + DG);
    f32x4 Sacc[8];
#pragma unroll
    for (int kt = 0; kt < 8; ++kt) Sacc[kt] = (f32x4){0.f, 0.f, 0.f, 0.f};
#pragma unroll 1
    for (int cc = 0; cc < NCHUNK; ++cc) {
        const int c = dir ? (NCHUNK - 1 - cc) : cc; const size_t t0 = (size_t)b * SEQ + c * CH;
        const bf16* TBp = TB + ((size_t)((b * NHEAD_D + h) * 64 + c) * 2 + dir) * 4096;
        v4u Traw[4][2];
#pragma unroll
        for (int it = 0; it < 4; ++it)
#pragma unroll
            for (int ks = 0; ks < 2; ++ks) { const bf16* p = TBp + (16 * it + i) * 64 + 32 * ks + 4 * g; const v2u lo = *(const v2u*)p, hi = *(const v2u*)(p + 16); Traw[it][ks] = (v4u){lo.x, lo.y, hi.x, hi.y}; }
        __syncthreads();
        {   const int hw = 2 * w + (lane >> 5), cg = lane & 31;
#pragma unroll
            for (int which = 0; which < 3; ++which) { float o[4][4];
                conv4x4(P, ARG_IN(6), b, c * CH + 4 * hw, which * TOKW + h * DNH + 4 * cg, o);
                LAS unsigned char* dst = which == 0 ? Ql : (which == 1 ? Kl : Vl); const int st = which == 0 ? DQ_S : (which == 1 ? DK_S : DV_S);
#pragma unroll
                for (int tt = 0; tt < 4; ++tt) { float r = 1.0f;
                    if (which < 2) r = (which == 0 ? 0.08838834764831845f : 1.0f) / sqrtf(hw_sum32((o[tt][0] * o[tt][0] + o[tt][1] * o[tt][1]) + (o[tt][2] * o[tt][2] + o[tt][3] * o[tt][3])) + EPS);
                    v2u wv; wv.x = pk2(o[tt][0] * r, o[tt][1] * r); wv.y = pk2(o[tt][2] * r, o[tt][3] * r); *(LAS v2u*)(dst + (4 * hw + tt) * st + 8 * cg) = wv; } }
        }
        if (w == 0) { float beta, cs; dn_gates(F, b, h, c, dir, lane, beta, cs); const float glast = __shfl(cs, dir ? 0 : 63);
            Gl[lane] = cs; Gl[64 + lane] = beta; Gl[128 + lane] = __expf(cs); Gl[192 + lane] = __expf(glast - cs); Gl[256 + lane] = beta * __expf(cs); if (lane == 0) Gl[320] = __expf(glast); }
        __syncthreads();
        {   bf16x8v kT[2];
#pragma unroll
            for (int ks = 0; ks < 2; ++ks) kT[ks] = frag_tr(Kl, DK_S, 32 * ks, 16 * w, i, g);
            f32x4 bwl[2], bwh[2];
#pragma unroll
            for (int ks = 0; ks < 2; ++ks) { bwl[ks] = *(const LAS f32x4*)(Gl + 256 + 32 * ks + 4 * g); bwh[ks] = *(const LAS f32x4*)(Gl + 256 + 32 * ks + 16 + 4 * g); }
#pragma unroll
            for (int it = 0; it < 4; ++it) { f32x4 acc = (f32x4){0.f, 0.f, 0.f, 0.f};
#pragma unroll
                for (int ks = 0; ks < 2; ++ks) acc = __builtin_amdgcn_mfma_f32_16x16x32_bf16(kT[ks], scale_frag(Traw[it][ks], bwl[ks], bwh[ks]), acc, 0, 0, 0);
                v2u wv; wv.x = pk2(-acc[0], -acc[1]); wv.y = pk2(-acc[2], -acc[3]); *(LAS v2u*)(Wl + (16 * it + i) * DW_S + (16 * w + 4 * g) * 2) = wv; }
#pragma unroll
            for (int tt = 0; tt < 2; ++tt) { const int id = 2 * w + tt, it = id >> 2, jt = id & 3; f32x4 acc = (f32x4){0.f, 0.f, 0.f, 0.f};
#pragma unroll
                for (int ks = 0; ks < 4; ++ks) { const bf16x8v a = *(const LAS bf16x8v*)(Kl + (16 * jt + i) * DK_S + (32 * ks + 8 * g) * 2), bb = *(const LAS bf16x8v*)(Ql + (16 * it + i) * DQ_S + (32 * ks + 8 * g) * 2);
                    acc = __builtin_amdgcn_mfma_f32_16x16x32_bf16(a, bb, acc, 0, 0, 0); }
                const int pi = 16 * it + i; const float gci = Gl[pi]; float v[4];
#pragma unroll
                for (int r = 0; r < 4; ++r) { const int pj = 16 * jt + 4 * g + r; const bool ok = dir ? (pj >= pi) : (pj <= pi); v[r] = ok ? acc[r] * __expf(gci - Gl[pj]) : 0.f; }
                v2u wv; wv.x = pk2(v[0], v[1]); wv.y = pk2(v[2], v[3]); *(LAS v2u*)(Il + pi * DI_S + (16 * jt + 4 * g) * 2) = wv; }
        }
        __syncthreads();
        {   bf16x8v Sb[4];
#pragma unroll
            for (int ks = 0; ks < 4; ++ks) Sb[ks] = frag_acc(Sacc[2 * ks], Sacc[2 * ks + 1]);
            f32x4 vacc[4], oacc[4];
            {   bf16x8v vT[2]; f32x4 btl[2], bth[2];
#pragma unroll
                for (int ks = 0; ks < 2; ++ks) { vT[ks] = frag_tr(Vl, DV_S, 32 * ks, 16 * w, i, g); btl[ks] = *(const LAS f32x4*)(Gl + 64 + 32 * ks + 4 * g); bth[ks] = *(const LAS f32x4*)(Gl + 64 + 32 * ks + 16 + 4 * g); }
#pragma unroll
                for (int it = 0; it < 4; ++it) { f32x4 acc = (f32x4){0.f, 0.f, 0.f, 0.f};
#pragma unroll
                    for (int ks = 0; ks < 2; ++ks) acc = __builtin_amdgcn_mfma_f32_16x16x32_bf16(scale_frag(Traw[it][ks], btl[ks], bth[ks]), vT[ks], acc, 0, 0, 0);
#pragma unroll
                    for (int ks = 0; ks < 4; ++ks) acc = __builtin_amdgcn_mfma_f32_16x16x32_bf16(frag_k2(Wl, 16 * it + i, DW_S, 32 * ks, g), Sb[ks], acc, 0, 0, 0);
                    vacc[it] = acc; }
            }
#pragma unroll
            for (int it = 0; it < 4; ++it) { f32x4 acc = (f32x4){0.f, 0.f, 0.f, 0.f};
#pragma unroll
                for (int ks = 0; ks < 4; ++ks) acc = __builtin_amdgcn_mfma_f32_16x16x32_bf16(frag_k2(Ql, 16 * it + i, DQ_S, 32 * ks, g), Sb[ks], acc, 0, 0, 0);
                const f32x4 egv = *(const LAS f32x4*)(Gl + 128 + 16 * it + 4 * g); oacc[it] = acc * egv; }
            bf16x8v Vb[2], Vk[2];
#pragma unroll
            for (int js = 0; js < 2; ++js) { const f32x4 e0 = *(const LAS f32x4*)(Gl + 192 + 32 * js + 4 * g), e1 = *(const LAS f32x4*)(Gl + 192 + 32 * js + 16 + 4 * g);
                Vb[js] = frag_acc(vacc[2 * js], vacc[2 * js + 1]); Vk[js] = frag_acc(vacc[2 * js] * e0, vacc[2 * js + 1] * e1); }
#pragma unroll
            for (int it = 0; it < 4; ++it) {
#pragma unroll
                for (int js = 0; js < 2; ++js) oacc[it] = __builtin_amdgcn_mfma_f32_16x16x32_bf16(frag_k2(Il, 16 * it + i, DI_S, 32 * js, g), Vb[js], oacc[it], 0, 0, 0);
#pragma unroll
                for (int r = 0; r < 4; ++r) OD[(t0 + 16 * it + 4 * g + r) * TOKW + h * DNH + 16 * w + i] = (bf16)f2bf(oacc[it][r]); }
            const float egl = Gl[320];
#pragma unroll
            for (int kt = 0; kt < 8; ++kt) { f32x4 acc = Sacc[kt] * egl;
#pragma unroll
                for (int js = 0; js < 2; ++js) acc = __builtin_amdgcn_mfma_f32_16x16x32_bf16(frag_tr(Kl, DK_S, 32 * js, 16 * kt, i, g), Vk[js], acc, 0, 0, 0);
                Sacc[kt] = acc; }
        }
    }
}
__device__ __forceinline__ void dn_gate(Frame& F) {
    const int gw = F.vcu * NWAVES + F.wave, NGW = F.G * NWAVES, lane = F.lane;
    bf16* MIX = WSP(F, bf16, WS_MIX); const float* O = WSP(F, const float, WS_Y); const float* onorm = ARG_IN(9);
    const float n0 = onorm[lane], n1 = onorm[64 + lane];
    for (int t = gw; t < T; t += NGW) {
#pragma unroll
        for (int h = 0; h < NHEAD_D; ++h) {
#if defined(MK_NAIVE_DN)
            const float o0 = O[(size_t)t * TOKW + h * DNH + lane], o1 = O[(size_t)t * TOKW + h * DNH + 64 + lane];
#else
            const bf16* of = WSP(F, const bf16, WS_OF) + (size_t)t * TOKW + h * DNH + lane; const bf16* ob = WSP(F, const bf16, WS_OB) + (size_t)t * TOKW + h * DNH + lane;
            const float o0 = bf2f(of[0]) + bf2f(ob[0]), o1 = bf2f(of[64]) + bf2f(ob[64]);
#endif
            const float r = 1.0f / sqrtf(wave_sum(o0 * o0 + o1 * o1) * (1.f / DNH) + EPS);
            bf16* zp = MIX + (size_t)t * D + h * DNH + lane;
            const float z0 = bf2f(zp[0]), z1 = bf2f(zp[64]);
            zp[0] = (bf16)f2bf(o0 * r * n0 * silu(z0)); zp[64] = (bf16)f2bf(o1 * r * n1 * silu(z1));
        }
    }
}
__device__ __forceinline__ void zero_f32(Frame& F, float* p, size_t n4) {
    const size_t gt = (size_t)F.vcu * (NWAVES * 64) + F.tid, NT = (size_t)F.G * (NWAVES * 64);
    for (size_t i = gt; i < n4; i += NT) ((f32x4*)p)[i] = (f32x4){0.f, 0.f, 0.f, 0.f};
}

struct Args { const float* in[19]; float* out; unsigned char* ws; int ph_lo, ph_hi; };
__global__ void __launch_bounds__(NWAVES * 64, 2) mk_fwd(Args args) {
    extern __shared__ __attribute__((aligned(16))) unsigned char lds[];
    Frame F;
    F.lds = (LAS unsigned char*)lds; F.ldsg = lds;
    F.MISC = (volatile LAS unsigned*)(F.lds + MISC_OFF);
    F.tid = threadIdx.x; F.lane = F.tid & 63; F.wave = __builtin_amdgcn_readfirstlane(F.tid >> 6);
    F.G = gridDim.x; { const int bx = blockIdx.x; F.vcu = (F.G % 8 == 0) ? (bx % 8) * (F.G / 8) + bx / 8 : bx; }
    F.ws = args.ws; F.out = args.out;
    F.ctl = (gu32*)(F.ws + WS_CTL);
    for (int u = F.tid; u < (LDS_BYTES - LDSCTL_OFF) / 4; u += NWAVES * 64) ((LAS unsigned*)(F.lds + LDSCTL_OFF))[u] = 0u;
    __syncthreads();
    XcdBarrier bar; bar.bar = (unsigned*)(F.ctl + CW_BAR); bar.x = 0; bar.st = nullptr;
    if (N_LAUNCHES == 1) bar = xcd_barrier_post((unsigned*)(F.ctl + CW_BAR), F.MISC + 8);
#define GRID_BAR() do { if (N_LAUNCHES == 1) xcd_barrier(bar); } while (0)
    Frame F0 = F;
#pragma unroll 1
    for (int pi = args.ph_lo; pi < args.ph_hi; ++pi) {
    { int tid = F0.tid, wave = F0.wave, vcu = F0.vcu, G = F0.G, bx = blockIdx.x; unsigned char* ws = F0.ws; float* out = F0.out;
      asm volatile("" : "+v"(tid), "+s"(wave), "+s"(vcu), "+s"(G), "+s"(ws), "+s"(out), "+s"(bx)); F.bx = bx;
      F.tid = tid; F.lane = tid & 63; F.wave = wave; F.vcu = vcu; F.G = G; F.ws = ws; F.out = out; }
    bf16* XN = WSP(F, bf16, WS_XN); bf16* MIX = WSP(F, bf16, WS_MIX); float* Y = WSP(F, float, WS_Y); bf16* BIG = WSP(F, bf16, WS_BIG);
    const int code = PROG[pi], ph = code & 15, arg = code >> 4;
    if (ph == 0) {
        transpose_w(F, ARG_IN(3), D, ATT_IN, WSP(F, bf16, WS_W_ATT_IN), ATT_IN, 0);
        transpose_w(F, ARG_IN(4), D, D, WSP(F, bf16, WS_W_ATT_OUT), D, 0);
        transpose_w(F, ARG_IN(5), D, DN_IN, WSP(F, bf16, WS_W_DN_IN), DN_IN_P, 1);
        transpose_w(F, ARG_IN(10), D, D, WSP(F, bf16, WS_W_DN_OUT), D, 0);
        for (int i = 0; i < 2; ++i) {
            transpose_w(F, ARG_IN(12) + (size_t)i * D * 512, D, 512, WSP(F, bf16, WS_W_MEMKV) + (size_t)i * 512 * D, 512, 0);
            transpose_w(F, ARG_IN(17) + (size_t)i * D * GU, D, GU, WSP(F, bf16, WS_W_GU) + (size_t)i * GU * D, GU, 2);
            transpose_w(F, ARG_IN(18) + (size_t)i * DFF * D, DFF, D, WSP(F, bf16, WS_W_DOWN) + (size_t)i * D * DFF, D, 0);
            rms_rows_bf16(F, ARG_IN(1), ARG_IN(11) + i * D, WSP(F, bf16, WS_MEMN) + (size_t)i * NB * MEML * D, NB * MEML);
        }
        rms_rows_bf16(F, ARG_IN(0), ARG_IN(13), XN, T);
    }
    else if (ph == 1 || ph == 8) {
        if (ph == 8) zero_f32(F, Y, (size_t)T * TOKW / 4);
        { const int N = ph == 1 ? ATT_IN : DN_IN_P;
          pg8::Gemm g{XN, WSP(F, bf16, ph == 1 ? WS_W_ATT_IN : WS_W_DN_IN), T, N, D}; pg8::StaticOrder S; S.init(T, N, F.G, F.bx);
          pg8::EpiRoute E{ph == 1 ? 0 : 1, BIG, ph == 1 ? ATT_IN : 3 * TOKW, MIX, D, WSP(F, float, WS_GATE)};
          pg8::gemm_phase<pg8::EpiRoute, pg8::StaticOrder, PG8_ALIGN, PG8_SP2>(F.lds + RING_OFF, g, S, E); }
        if (ph == 1) {
#pragma unroll 1
            for (int i = 0; i < 2; ++i) {
                pg8::Gemm g{WSP(F, bf16, WS_MEMN) + (size_t)i * NB * MEML * D, WSP(F, bf16, WS_W_MEMKV) + (size_t)i * 512 * D, NB * MEML, 512, D};
                pg8::StaticOrder S; S.init(NB * MEML, 512, F.G, (F.bx + 64 * (i + 1)) % F.G);
                pg8::EpiRoute E{0, WSP(F, bf16, WS_MEMKV) + (size_t)i * NB * MEML * 512, 512, nullptr, 0, nullptr};
                pg8::gemm_phase<pg8::EpiRoute, pg8::StaticOrder, PG8_ALIGN, PG8_SP2>(F.lds + RING_OFF, g, S, E);
            }
        }
    }
    else if (ph == 2) {
#if defined(MK_NAIVE_ATTN)
        attn_band_naive(F);
        attn_mem_naive(F, BIG + 3 * TOKW, ATT_IN, WSP(F, const bf16, WS_MEMKV), F.vcu, F.G);
#else
        attn_phase_fast(F, false, F.vcu, F.G);
#endif
    }
    else if (ph == 3) { lse_mix(F); }
    else if (ph == 4 || ph == 7) {
        const bf16* A = ph == 4 ? MIX : BIG; const int K = ph == 4 ? D : DFF;
        const bf16* W = ph == 4 ? WSP(F, bf16, arg ? WS_W_DN_OUT : WS_W_ATT_OUT) : WSP(F, bf16, WS_W_DOWN) + (size_t)arg * D * DFF;
        pg8::Gemm g{A, W, T, D, K}; pg8::StaticOrder S; S.init(T, D, F.G, F.bx); pg8::EpiF32 E{Y, D};
        pg8::gemm_phase<pg8::EpiF32, pg8::StaticOrder, PG8_ALIGN, PG8_SP2>(F.lds + RING_OFF, g, S, E);
    }
    else if (ph == 5) {
        const float* xold = arg == 0 ? ARG_IN(0) : F.out;
        const float* gpost = arg == 0 ? ARG_IN(14) : (arg == 1 ? ARG_IN(16) : (arg == 2 ? ARG_IN(14) + D : ARG_IN(16) + D));
        const float* gpre = arg == 0 ? ARG_IN(15) : (arg == 1 ? ARG_IN(13) + D : (arg == 2 ? ARG_IN(15) + D : nullptr));
        row_pass(F, xold, Y, gpost, F.out, gpre, XN);
    }
    else if (ph == 6) {
        pg8::Gemm g{XN, WSP(F, bf16, WS_W_GU) + (size_t)arg * GU * D, T, GU, D}; pg8::StaticOrder S; S.init(T, GU, F.G, F.bx); pg8::EpiSwiglu E{BIG, DFF};
        pg8::gemm_phase<pg8::EpiSwiglu, pg8::StaticOrder, PG8_ALIGN, PG8_SP2>(F.lds + RING_OFF, g, S, E);
    }
    else if (ph == 9) {
        const bool split = F.G >= 192;
#pragma unroll 1
#if defined(MK_NAIVE_DN)
        for (int c = F.vcu; c < 96; c += F.G) dn_naive(F, c);
#else
        for (int c = F.vcu; c < 96; c += F.G) dn_scan(F, c);
#endif
#if defined(MK_NAIVE_ATTN)
        if (!split || F.vcu >= 96) attn_mem_naive(F, MIX + TOKW, D, WSP(F, const bf16, WS_MEMKV) + (size_t)NB * MEML * 512, split ? F.vcu - 96 : F.vcu, split ? F.G - 96 : F.G);
#else
        if (!split || F.vcu >= 96) attn_phase_fast(F, true, split ? F.vcu - 96 : F.vcu, split ? F.G - 96 : F.G);
#endif
    }
    else if (ph == 10) { dn_gate(F); }
    else if (ph == 11) {
#if !defined(MK_NAIVE_DN)
#pragma unroll 1
        for (int u = F.vcu; u < NB * NHEAD_D * NCHUNK; u += F.G) dn_tsolve_unit(F, u);
#endif
    }
    if (pi + 1 < args.ph_hi) GRID_BAR();
    }
}

extern "C" void kernel_launch(void* const* d_in, const int* in_sizes, int n_in, void* d_out, int out_size, void* d_ws, size_t ws_size, hipStream_t stream) {
    static int grid = 0;
    if (grid == 0) {
        if (n_in != 19 || in_sizes[0] != T * D || out_size != T * D || ws_size < WS_END) { fprintf(stderr, "kernel_launch: unexpected shapes (n_in %d, in0 %d, out %d, ws %zu)\n", n_in, n_in > 0 ? in_sizes[0] : -1, out_size, ws_size); grid = -1; return; }
        int dev = 0, cus = 0, per_cu = 0;
        if (hipGetDevice(&dev) != hipSuccess || hipDeviceGetAttribute(&cus, hipDeviceAttributeMultiprocessorCount, dev) != hipSuccess) { grid = -1; return; }
        if (hipFuncSetAttribute((const void*)mk_fwd, hipFuncAttributeMaxDynamicSharedMemorySize, LDS_BYTES) != hipSuccess) { fprintf(stderr, "kernel_launch: hipFuncSetAttribute failed\n"); grid = -1; return; }
        if (hipOccupancyMaxActiveBlocksPerMultiprocessor(&per_cu, (const void*)mk_fwd, NWAVES * 64, LDS_BYTES) != hipSuccess || per_cu < 1)
            fprintf(stderr, "kernel_launch: note: occupancy query reports %d workgroups per CU\n", per_cu);
        (void)hipGetLastError();
        grid = cus;
    }
    if (grid < 0) return;
    if (hipMemsetAsync((char*)d_ws + WS_CTL, 0, CTL_ZERO_BYTES, stream) != hipSuccess) { fprintf(stderr, "kernel_launch: hipMemsetAsync failed\n"); return; }
    Args a{};
    for (int i = 0; i < 19; ++i) a.in[i] = (const float*)d_in[i];
    a.out = (float*)d_out; a.ws = (unsigned char*)d_ws;
    for (int li = 0; li < N_LAUNCHES; ++li) {
        a.ph_lo = (N_LAUNCHES == 1) ? 0 : li; a.ph_hi = (N_LAUNCHES == 1) ? N_PHASES : li + 1;
        hipLaunchKernelGGL(mk_fwd, dim3(grid), dim3(NWAVES * 64), LDS_BYTES, stream, a);
        const hipError_t le = hipPeekAtLastError();
        if (le != hipSuccess) { fprintf(stderr, "kernel_launch: launch %d failed: %s\n", li, hipGetErrorName(le)); break; }
    }
}
```

```cpp
#include <hip/hip_runtime.h>
#include <cstdio>
#include <cstdint>
#define MK_N_LAUNCHES 1
#define MK_PROG 0, 1, 2, 3, 4, 5, 6, 7, 5 | 16, 8, 12, 11, 9, 10, 4 | 16, 5 | 32, 6 | 16, 7 | 16, 5 | 48

namespace pg8 {
#define PG8_LAS __attribute__((address_space(3)))
typedef unsigned short bf16_t;
typedef short bf16x8 __attribute__((ext_vector_type(8)));
typedef float f32x4 __attribute__((ext_vector_type(4)));
typedef unsigned u32x4 __attribute__((ext_vector_type(4)));
constexpr int BM = 256, BK = 64, HALF = 128, HTB = HALF * BK * 2  , STAGE_BYTES = 8 * HTB, NXCD = 8, WGM = 8;

__host__ __device__ __forceinline__ int lds_byte(int r, int c) { const int st = (r >> 4) * 2 + (c >> 5), rr = r & 15, cc = c & 31, ob = rr * 64 + cc * 2; return st * 1024 + (ob ^ (((ob >> 9) & 1) << 5)); }
__host__ __device__ __forceinline__ void stage_rc(int b, int& R, int& C) { const int st = b / 1024, sb = b % 1024, swz = sb ^ (((sb >> 9) & 1) << 5); R = (st >> 1) * 16 + swz / 64; C = (st & 1) * 32 + (swz % 64) / 2; }
__host__ __device__ __forceinline__ int perm32(int rho) { const int n = rho >> 4, i = rho & 15; return 8 * (i >> 2) + 4 * n + (i & 3); }

struct Unit { int pm, pn; };
struct Gemm { const bf16_t* A; const bf16_t* Bt; int M, N, K; };

struct StaticOrder {
    int nM, nN, nwg, G, c;
    __host__ __device__ void init(int M, int N, int G_, int c_) { nM = M / BM; nN = N / BM; nwg = nM * nN; G = G_; c = c_; }
    __host__ __device__ bool next(int i, Unit& u) const {
        const long L = (long)i * G + c; if (L >= nwg) return false;
        int wgid = (int)L; { const int q = nwg / NXCD, r = nwg % NXCD, xcd = wgid % NXCD, off = wgid / NXCD; wgid = (xcd < r ? xcd * (q + 1) : r * (q + 1) + (xcd - r) * q) + off; }
        const int nig = WGM * nN, gid = wgid / nig, fm = gid * WGM, gsz = (nM - fm) < WGM ? (nM - fm) : WGM;
        u.pm = fm + ((wgid % nig) % gsz); u.pn = (wgid % nig) / gsz; return true;
    }
    __device__ __forceinline__ void a_ready(const Unit&) const {}
    __device__ __forceinline__ void done(const Unit&) const {}
};

__device__ __forceinline__ unsigned cvt_pk_bf16(float lo, float hi) { unsigned r; asm volatile("v_cvt_pk_bf16_f32 %0, %1, %2" : "=v"(r) : "v"(lo), "v"(hi)); return r; }
typedef float f32x2 __attribute__((ext_vector_type(2)));
#define PG8_GAS __attribute__((address_space(1)))
struct EpiF32 {
    static constexpr bool PERM = false, AFTER_DRAIN = false;
    float* C; int ldc;
    __device__ __forceinline__ void operator()(const f32x4 (&acc)[2][2][4][2], const Unit& u, int wr, int wc, int fr, int fq) const {
        const int row0 = u.pm * BM + wr * 64 + fr, col0 = u.pn * BM + wc * 32 + 4 * fq;
#pragma unroll
        for (int ai = 0; ai < 2; ++ai)
#pragma unroll
            for (int m = 0; m < 4; ++m) { float* rowp = C + (size_t)(row0 + ai * HALF + m * 16) * ldc + col0;
#pragma unroll
                for (int bj = 0; bj < 2; ++bj)
#pragma unroll
                    for (int n = 0; n < 2; ++n) *(PG8_GAS f32x4*)(rowp + bj * HALF + n * 16) = acc[ai][bj][m][n]; }
    }
};
struct EpiRoute {
    static constexpr bool PERM = true, AFTER_DRAIN = false;
    int mode; bf16_t* O; int ldc; bf16_t* O2; int ldc2; float* gate;
    __device__ __forceinline__ void operator()(const f32x4 (&acc)[2][2][4][2], const Unit& u, int wr, int wc, int fr, int fq) const {
        const int row0 = u.pm * BM + wr * 64 + fr;
        if (mode == 1 && u.pn == 13) {
            if (wc == 0 && fq < 3) {
#pragma unroll
                for (int ai = 0; ai < 2; ++ai)
#pragma unroll
                    for (int m = 0; m < 4; ++m) { float* rowp = gate + (size_t)(row0 + ai * HALF + m * 16) * 24 + 8 * fq;
                        *(PG8_GAS f32x4*)(rowp) = acc[ai][0][m][0]; *(PG8_GAS f32x4*)(rowp + 4) = acc[ai][0][m][1]; }
            }
            return;
        }
        bf16_t* base = O; int ld = ldc; int colt = u.pn * BM;
        if (mode == 1 && u.pn >= 9) { base = O2; ld = ldc2; colt = (u.pn - 9) * BM; }
        const int col0 = colt + wc * 32 + 8 * fq;
#pragma unroll
        for (int ai = 0; ai < 2; ++ai)
#pragma unroll
            for (int m = 0; m < 4; ++m) { bf16_t* rowp = base + (size_t)(row0 + ai * HALF + m * 16) * ld + col0;
#pragma unroll
                for (int bj = 0; bj < 2; ++bj) { const f32x4 v0 = acc[ai][bj][m][0], v1 = acc[ai][bj][m][1];
                    u32x4 w; w.x = cvt_pk_bf16(v0[0], v0[1]); w.y = cvt_pk_bf16(v0[2], v0[3]); w.z = cvt_pk_bf16(v1[0], v1[1]); w.w = cvt_pk_bf16(v1[2], v1[3]);
                    *(PG8_GAS u32x4*)(rowp + bj * HALF) = w; } }
    }
};
__device__ __forceinline__ float silu_f(float x) { return x * __builtin_amdgcn_rcpf(1.0f + __expf(-x)); }
struct EpiSwiglu {
    static constexpr bool PERM = true, AFTER_DRAIN = false;
    bf16_t* H; int ldh;
    __device__ __forceinline__ void operator()(const f32x4 (&acc)[2][2][4][2], const Unit& u, int wr, int wc, int fr, int fq) const {
        const int row0 = u.pm * BM + wr * 64 + fr, col0 = u.pn * HALF + wc * 32 + 8 * fq;
#pragma unroll
        for (int ai = 0; ai < 2; ++ai)
#pragma unroll
            for (int m = 0; m < 4; ++m) { bf16_t* rowp = H + (size_t)(row0 + ai * HALF + m * 16) * ldh + col0;
                const f32x4 g0 = acc[ai][0][m][0], g1 = acc[ai][0][m][1], u0 = acc[ai][1][m][0], u1 = acc[ai][1][m][1];
                u32x4 w; w.x = cvt_pk_bf16(silu_f(g0[0]) * u0[0], silu_f(g0[1]) * u0[1]); w.y = cvt_pk_bf16(silu_f(g0[2]) * u0[2], silu_f(g0[3]) * u0[3]);
                w.z = cvt_pk_bf16(silu_f(g1[0]) * u1[0], silu_f(g1[1]) * u1[1]); w.w = cvt_pk_bf16(silu_f(g1[2]) * u1[2], silu_f(g1[3]) * u1[3]);
                *(PG8_GAS u32x4*)(rowp) = w; }
    }
};

template <class Epi, class Sched, bool ALIGN_EPI = false, bool SP2 = false>
__device__ __forceinline__ void gemm_phase(PG8_LAS unsigned char* lds, const Gemm g, const Sched& S, const Epi& E) {
    int tid_ = threadIdx.x; asm volatile("" : "+v"(tid_));
    const int tid = tid_, wid = __builtin_amdgcn_readfirstlane(tid >> 6), lane = tid & 63, wr = wid >> 2, wc = wid & 3, fr = lane & 15, fq = lane >> 4;
    const int K = g.K, nt = K / BK;
    unsigned voffA[2], voffB[2];
#pragma unroll
    for (int i = 0; i < 2; ++i) { int R, C; stage_rc(tid * 16 + i * 8192, R, C); const int Rb = Epi::PERM ? ((R & ~31) + perm32(R & 31)) : R;
        voffA[i] = (unsigned)(R * K + C) * 2u; voffB[i] = (unsigned)(Rb * K + C) * 2u; }
    const size_t kstep = (size_t)(BK * 2);
    const size_t hstep = (size_t)HALF * K * 2;
    const size_t tstep = 2 * hstep;
    const unsigned ldsw = (unsigned)wid * 1024u;
    const int aoff = lds_byte(wr * 64 + fr, fq * 8), boff = lds_byte(wc * 32 + fr, fq * 8);
#define PG8_SA(b, h) (((b) * 2 + (h)) * HTB)
#define PG8_SB(b, h) ((4 + (b) * 2 + (h)) * HTB)
#define PG8_STAGE(bufoff, gbase, voff) do { _Pragma("unroll") for (int _i = 0; _i < 2; ++_i) \
        __builtin_amdgcn_global_load_lds((const unsigned*)((const char*)(gbase) + (voff)[_i]), (PG8_LAS unsigned*)(lds + (bufoff) + ldsw + _i * 8192), 16, 0, 0); } while (0)
#define PG8_LDA(dst, b, h) do { _Pragma("unroll") for (int m = 0; m < 4; ++m) _Pragma("unroll") for (int k = 0; k < 2; ++k) dst[m][k] = *(const PG8_LAS bf16x8*)(lds + PG8_SA(b, h) + aoff + m * 2048 + k * 1024); } while (0)
#define PG8_LDB(dst, b, h) do { _Pragma("unroll") for (int n = 0; n < 2; ++n) _Pragma("unroll") for (int k = 0; k < 2; ++k) dst[n][k] = *(const PG8_LAS bf16x8*)(lds + PG8_SB(b, h) + boff + n * 2048 + k * 1024); } while (0)
#define PG8_MMA(ai, bj, At, Bt) do { __builtin_amdgcn_s_setprio(1); _Pragma("unroll") for (int m = 0; m < 4; ++m) _Pragma("unroll") for (int n = 0; n < 2; ++n) _Pragma("unroll") for (int k = 0; k < 2; ++k) \
        acc[ai][bj][m][n] = __builtin_amdgcn_mfma_f32_16x16x32_bf16(Bt[n][k], At[m][k], acc[ai][bj][m][n], 0, 0, 0); __builtin_amdgcn_s_setprio(0); } while (0)
#define PG8_WAIT_V(n) asm volatile("s_waitcnt vmcnt(" #n ")" ::: "memory")
#define PG8_WAIT_L(n) asm volatile("s_waitcnt lgkmcnt(" #n ")" ::: "memory")
#define PG8_BAR __builtin_amdgcn_s_barrier()
#define PG8_SCHED __builtin_amdgcn_sched_barrier(0)
    Unit cur, nxt; int ui = 0;
    if (!S.next(0, cur)) return;
    f32x4 acc[2][2][4][2];
#pragma unroll
    for (int a = 0; a < 2; ++a)
#pragma unroll
        for (int b = 0; b < 2; ++b)
#pragma unroll
            for (int m = 0; m < 4; ++m)
#pragma unroll
                for (int n = 0; n < 2; ++n) acc[a][b][m][n] = (f32x4){0.f, 0.f, 0.f, 0.f};
    bf16x8 At[4][2], B0[2][2], B1[2][2];
    const char* cA = (const char*)g.A + (size_t)cur.pm * tstep; const char* cB = (const char*)g.Bt + (size_t)cur.pn * tstep;
    S.a_ready(cur);
    if constexpr (SP2) {
        PG8_STAGE(PG8_SB(0, 0), cB, voffB); PG8_STAGE(PG8_SB(0, 1), cB + hstep, voffB); PG8_STAGE(PG8_SA(0, 0), cA, voffA); PG8_STAGE(PG8_SA(0, 1), cA + hstep, voffA);
        if (wr == 1) PG8_BAR;
        PG8_WAIT_V(2); PG8_BAR;
        PG8_STAGE(PG8_SB(1, 0), cB + kstep, voffB); PG8_STAGE(PG8_SA(1, 0), cA + kstep, voffA); PG8_STAGE(PG8_SB(1, 1), cB + hstep + kstep, voffB);
        PG8_WAIT_V(6); PG8_BAR;
    } else {
        PG8_STAGE(PG8_SB(0, 0), cB, voffB); PG8_STAGE(PG8_SA(0, 0), cA, voffA); PG8_STAGE(PG8_SB(0, 1), cB + hstep, voffB); PG8_STAGE(PG8_SA(0, 1), cA + hstep, voffA);
        if (wr == 1) PG8_BAR;
        PG8_WAIT_V(4); PG8_BAR;
        PG8_STAGE(PG8_SB(1, 0), cB + kstep, voffB); PG8_STAGE(PG8_SA(1, 0), cA + kstep, voffA); PG8_STAGE(PG8_SB(1, 1), cB + hstep + kstep, voffB);
        PG8_WAIT_V(6); PG8_BAR;
    }
    for (;;) {
        const bool has_next = S.next(ui + 1, nxt);
        const char* nA = has_next ? (const char*)g.A + (size_t)nxt.pm * tstep : cA; const char* nB = has_next ? (const char*)g.Bt + (size_t)nxt.pn * tstep : cB;
        for (int t = 0; t < nt; t += 2) {
            const bool last = (t == nt - 2);
            const char* a1 = cA + (size_t)(t + 1) * kstep;
            const char* a2 = last ? nA : cA + (size_t)(t + 2) * kstep; const char* b2 = last ? nB : cB + (size_t)(t + 2) * kstep;
            const char* a3 = a2 + kstep; const char* b3 = b2 + kstep;
            if (last && has_next) S.a_ready(nxt);
            if constexpr (SP2) {
            PG8_LDB(B0, 0, 0); PG8_LDB(B1, 0, 1); PG8_SCHED; PG8_LDA(At, 0, 0); PG8_STAGE(PG8_SA(1, 1), a1 + hstep, voffA);
            PG8_WAIT_V(8); PG8_WAIT_L(0); PG8_BAR; PG8_MMA(0, 0, At, B0); PG8_MMA(0, 1, At, B1); PG8_BAR; PG8_SCHED;
            PG8_LDA(At, 0, 1); PG8_STAGE(PG8_SB(0, 0), b2, voffB); PG8_STAGE(PG8_SB(0, 1), b2 + hstep, voffB); PG8_STAGE(PG8_SA(0, 0), a2, voffA);
            PG8_WAIT_V(8); PG8_WAIT_L(0); PG8_BAR; PG8_MMA(1, 0, At, B0); PG8_MMA(1, 1, At, B1); PG8_BAR; PG8_SCHED;
            PG8_LDB(B0, 1, 0); PG8_LDB(B1, 1, 1); PG8_SCHED; PG8_LDA(At, 1, 0); PG8_STAGE(PG8_SA(0, 1), a2 + hstep, voffA);
            PG8_WAIT_V(8); PG8_WAIT_L(0); PG8_BAR; PG8_MMA(0, 0, At, B0); PG8_MMA(0, 1, At, B1); PG8_BAR; PG8_SCHED;
            PG8_LDA(At, 1, 1); PG8_STAGE(PG8_SB(1, 0), b3, voffB); PG8_STAGE(PG8_SB(1, 1), b3 + hstep, voffB); PG8_STAGE(PG8_SA(1, 0), a3, voffA);
            PG8_WAIT_V(8); PG8_WAIT_L(0); PG8_BAR; PG8_MMA(1, 0, At, B0); PG8_MMA(1, 1, At, B1); PG8_BAR; PG8_SCHED;
            } else {
            PG8_LDB(B0, 0, 0); PG8_SCHED; PG8_LDA(At, 0, 0); PG8_STAGE(PG8_SA(1, 1), a1 + hstep, voffA);
            PG8_WAIT_L(8); PG8_BAR; PG8_WAIT_L(0); PG8_MMA(0, 0, At, B0); PG8_BAR; PG8_SCHED;
            PG8_LDB(B1, 0, 1); PG8_STAGE(PG8_SB(0, 0), b2, voffB);
            PG8_BAR; PG8_WAIT_L(0); PG8_MMA(0, 1, At, B1); PG8_BAR;
            PG8_LDA(At, 0, 1); PG8_STAGE(PG8_SA(0, 0), a2, voffA);
            PG8_BAR; PG8_WAIT_L(0); PG8_MMA(1, 0, At, B0); PG8_BAR; PG8_SCHED;
            PG8_STAGE(PG8_SB(0, 1), b2 + hstep, voffB);
            PG8_WAIT_V(6); PG8_BAR; PG8_MMA(1, 1, At, B1); PG8_BAR;
            PG8_LDB(B0, 1, 0); PG8_SCHED; PG8_LDA(At, 1, 0); PG8_STAGE(PG8_SA(0, 1), a2 + hstep, voffA);
            PG8_WAIT_L(8); PG8_BAR; PG8_WAIT_L(0); PG8_MMA(0, 0, At, B0); PG8_BAR; PG8_SCHED;
            PG8_LDB(B1, 1, 1); PG8_STAGE(PG8_SB(1, 0), b3, voffB);
            PG8_BAR; PG8_WAIT_L(0); PG8_MMA(0, 1, At, B1); PG8_BAR;
            PG8_LDA(At, 1, 1); PG8_STAGE(PG8_SA(1, 0), a3, voffA);
            PG8_BAR; PG8_WAIT_L(0); PG8_MMA(1, 0, At, B0); PG8_BAR; PG8_SCHED;
            PG8_STAGE(PG8_SB(1, 1), b3 + hstep, voffB);
            PG8_WAIT_V(6); PG8_BAR; PG8_MMA(1, 1, At, B1); PG8_BAR;
            }
        }
        if constexpr (ALIGN_EPI) { if (wr == 0) PG8_BAR; }
        if constexpr (!Epi::AFTER_DRAIN) { E(acc, cur, wr, wc, fr, fq); S.done(cur); }
        if (!has_next) break;
#pragma unroll
        for (int a = 0; a < 2; ++a)
#pragma unroll
            for (int b = 0; b < 2; ++b)
#pragma unroll
                for (int m = 0; m < 4; ++m)
#pragma unroll
                    for (int n = 0; n < 2; ++n) acc[a][b][m][n] = (f32x4){0.f, 0.f, 0.f, 0.f};
        cur = nxt; cA = nA; cB = nB; ++ui;
        if constexpr (ALIGN_EPI) { if (wr == 1) PG8_BAR; }
    }
    PG8_WAIT_V(0);
    if constexpr (!ALIGN_EPI) { if (wr == 0) PG8_BAR; }
    PG8_BAR;
    if constexpr (Epi::AFTER_DRAIN) { E.fused(acc, cur, wr, wc, fr, fq, lds, wid, lane); S.done(cur); }
#undef PG8_SA
#undef PG8_SB
#undef PG8_STAGE
#undef PG8_LDA
#undef PG8_LDB
#undef PG8_MMA
#undef PG8_WAIT_V
#undef PG8_WAIT_L
#undef PG8_BAR
#undef PG8_SCHED
}
}
constexpr int NWAVES = 8;
#ifndef MK_N_LAUNCHES
#define MK_N_LAUNCHES 1
#endif
#ifndef MK_SCAN_VAR
#define MK_SCAN_VAR 3
#endif
#ifndef MK_PROG
#define MK_PROG 0, 1, 2, 3, 4, 5, 6, 7, 5 | 16, 8, 12, 11, 9, 10, 4 | 16, 5 | 32, 6 | 16, 7 | 16, 5 | 48
#endif
__device__ const int PROG[] = {MK_PROG};
constexpr int PROG_HOST[] = {MK_PROG};
constexpr int N_PHASES = sizeof(PROG_HOST) / sizeof(int);
constexpr int N_LAUNCHES = MK_N_LAUNCHES;
#ifndef PG8_SP2
#define PG8_SP2 true
#endif
#ifndef PG8_ALIGN
#define PG8_ALIGN true
#endif

constexpr int NB = 8, SEQ = 4096, D = 1024, T = NB * SEQ;
constexpr int TOKW = 768, MEMW = 256, MEML = 256;
constexpr int ATT_IN = 2560, DN_IN = 3352, DN_IN_P = 3584, DFF = 2816, GU = 2 * DFF;
constexpr int NHEAD_A = 12, NHEAD_D = 6, DNH = 128, NCHUNK = 64, CH = 64;
constexpr float EPS = 1e-6f;

constexpr size_t MiB = 1u << 20;
constexpr size_t WS_CTL = 0, CTL_ZERO_BYTES = 64 * 1024;
constexpr size_t WS_W_ATT_IN = 2 * MiB;
constexpr size_t WS_W_ATT_OUT = 7 * MiB;
constexpr size_t WS_W_DN_IN = 9 * MiB;
constexpr size_t WS_W_DN_OUT = 16 * MiB;
constexpr size_t WS_W_MEMKV = 18 * MiB;
constexpr size_t WS_W_GU = 20 * MiB;
constexpr size_t WS_W_DOWN = 42 * MiB;
constexpr size_t WS_MEMN = 54 * MiB;
constexpr size_t WS_MEMKV = 62 * MiB;
constexpr size_t WS_LSE = 66 * MiB;
constexpr size_t WS_GATE = 68 * MiB;
constexpr size_t WS_G2 = 72 * MiB;
constexpr size_t WS_MIX = 80 * MiB;
constexpr size_t WS_XN = 144 * MiB;
constexpr size_t WS_Y = 208 * MiB;
constexpr size_t WS_BIG = 336 * MiB;
constexpr size_t WS_END = 512 * MiB;
constexpr int CW_BAR = 4096;

constexpr int RING_OFF = 0, RING_BYTES = 131072;
constexpr int LDS_BYTES = 163840;
constexpr int LDSCTL_OFF = LDS_BYTES - 1024, MISC_OFF = LDSCTL_OFF + 320;

#define GAS __attribute__((address_space(1)))
#define LAS __attribute__((address_space(3)))
typedef unsigned short bf16;
typedef unsigned v4u __attribute__((ext_vector_type(4)));
typedef unsigned v2u __attribute__((ext_vector_type(2)));
typedef float f32x4 __attribute__((ext_vector_type(4)));
typedef GAS unsigned gu32;
#define RLX_AGENT __ATOMIC_RELAXED, __HIP_MEMORY_SCOPE_AGENT
#define LDS_WAIT() asm volatile("s_waitcnt lgkmcnt(0)" ::: "memory")
template <class Tp> __device__ __forceinline__ Tp gld(const void* p) { return *(const GAS Tp*)p; }
template <class Tp> __device__ __forceinline__ void gst(void* p, Tp v) { *(GAS Tp*)p = v; }
typedef float f32x2_t __attribute__((ext_vector_type(2))); typedef __bf16 bf16x2_t __attribute__((ext_vector_type(2)));
__device__ __forceinline__ unsigned pk2(float lo, float hi) { f32x2_t v = {lo, hi}; bf16x2_t b = __builtin_convertvector(v, bf16x2_t); return __builtin_bit_cast(unsigned, b); }
__device__ __forceinline__ unsigned f2bf(float f) { return pk2(f, 0.f) & 0xffffu; }
__device__ __forceinline__ float bf2f(unsigned b) { return __builtin_bit_cast(float, b << 16); }
__device__ __forceinline__ float bflo(unsigned w) { return __builtin_bit_cast(float, w << 16); }
__device__ __forceinline__ float bfhi(unsigned w) { return __builtin_bit_cast(float, w & 0xffff0000u); }
__device__ __forceinline__ float wave_sum(float v) {
#pragma unroll
    for (int o = 1; o < 64; o <<= 1) v += __shfl_xor(v, o);
    return v;
}
__device__ __forceinline__ float wave_max(float v) {
#pragma unroll
    for (int o = 1; o < 64; o <<= 1) v = fmaxf(v, __shfl_xor(v, o));
    return v;
}
__device__ __forceinline__ float silu(float x) { return x / (1.0f + __expf(-x)); }

#define XB_TMO      128
#define XB_XCNT(j)  (256  + 64 * (j))
#define XB_XSUB(j)  (1280 + 64 * (j))
#define XB_XGEN(j)  (2304 + 64 * (j))
#define XB_TOP      3328
#define XB_TOPGEN   3392
#define XCD_BAR_WORDS 3456
#define XB_SPIN_CAP (1u << 18)

__device__ __forceinline__ unsigned xb_ld(unsigned* p)              { return __hip_atomic_load(p, __ATOMIC_RELAXED, __HIP_MEMORY_SCOPE_AGENT); }
__device__ __forceinline__ unsigned xb_add(unsigned* p, unsigned v) { return __hip_atomic_fetch_add(p, v, __ATOMIC_RELAXED, __HIP_MEMORY_SCOPE_AGENT); }
__device__ __forceinline__ unsigned xb_xcc_id() { return (unsigned)__builtin_amdgcn_s_getreg((3 << 11) | 20) & 0xFu; }
#define XB_SPIN(cond, bar) do { unsigned _sp = 0; while (cond) { __builtin_amdgcn_s_sleep(1); \
    if ((++_sp & 255u) == 0u) { if (xb_ld(&(bar)[XB_TMO])) break; if (_sp > XB_SPIN_CAP) { atomicAdd(&(bar)[XB_TMO], 1u); break; } } } } while (0)

struct XcdBarrier {
    unsigned* bar; unsigned x;
    volatile LAS unsigned* st;
};

__device__ __forceinline__ XcdBarrier xcd_barrier_post(unsigned* bar, volatile LAS unsigned* st) {
    XcdBarrier b; b.bar = bar; b.x = xb_xcc_id(); b.st = st;
    if (threadIdx.x == 0) (void)xb_add(&bar[XB_XCNT(b.x)], 1u);
    return b;
}
__device__ __forceinline__ void xcd_barrier_complete(unsigned* bar, unsigned x, unsigned& nloc, unsigned& nx) {
    const unsigned G = gridDim.x * gridDim.y * gridDim.z;
    unsigned sum, cnt, mine, sp = 0u;
    for (;;) {
        sum = 0u; cnt = 0u; mine = 0u;
#pragma unroll
        for (unsigned j = 0; j < 16; ++j) { const unsigned c = xb_ld(&bar[XB_XCNT(j)]); sum += c; cnt += (c > 0u) ? 1u : 0u; mine = (j == x) ? c : mine; }
        if (sum == G) break;
        __builtin_amdgcn_s_sleep(1);
        if ((++sp & 255u) == 0u) { if (xb_ld(&bar[XB_TMO])) break; if (sp > XB_SPIN_CAP) { atomicAdd(&bar[XB_TMO], 1u); break; } }
    }
    nloc = mine > 0u ? mine : 1u; nx = cnt > 0u ? cnt : 1u;
}

__device__ __forceinline__ void xcd_barrier(const XcdBarrier& b) {
    asm volatile("s_waitcnt vmcnt(0)" ::: "memory");
    __syncthreads();
    if (threadIdx.x == 0) {
        unsigned* bar = b.bar;
        __builtin_amdgcn_s_waitcnt(0);
        unsigned nloc = b.st[0], nx = b.st[1];
        if (nloc == 0u) { xcd_barrier_complete(bar, b.x, nloc, nx); b.st[0] = nloc; b.st[1] = nx; }
        const unsigned old = xb_add(&bar[XB_XSUB(b.x)], 1u);
        const unsigned gen = old / nloc;
        if (old + 1u == (gen + 1u) * nloc) {
            __builtin_amdgcn_fence(__ATOMIC_RELEASE, "agent");
            asm volatile("s_waitcnt vmcnt(0)" ::: "memory");
            const unsigned og = xb_add(&bar[XB_TOP], 1u);
            const unsigned tg = og / nx;
            if (og + 1u == (tg + 1u) * nx) xb_add(&bar[XB_TOPGEN], 1u);
            else XB_SPIN(xb_ld(&bar[XB_TOPGEN]) == tg, bar);
            __builtin_amdgcn_fence(__ATOMIC_ACQUIRE, "agent");
            xb_add(&bar[XB_XGEN(b.x)], 1u);
            asm volatile("s_waitcnt vmcnt(0)" ::: "memory");
        } else {
            XB_SPIN(xb_ld(&bar[XB_XGEN(b.x)]) == gen, bar);
            __builtin_amdgcn_fence(__ATOMIC_ACQUIRE, "agent");
            asm volatile("s_waitcnt vmcnt(0)" ::: "memory");
        }
    }
    __syncthreads();
}


__device__ const unsigned char BUCKET[3][132] = {
{11,11,11,11,11,11,11,11,11,11,11,11,11,11,11,10,10,10,10,10,10,10,10,10,10,10,10,10,10,10,10,10,10,10,10,10,10,10,9,9,9,9,9,9,9,9,9,9,9,9,8,8,8,8,8,8,8,7,6,5,4,3,2,1,0,17,18,19,20,21,22,23,24,24,24,24,24,24,24,25,25,25,25,25,25,25,25,25,25,25,25,26,26,26,26,26,26,26,26,26,26,26,26,26,26,26,26,26,26,26,26,26,26,26,27,27,27,27,27,27,27,27,27,27,27,27,27,27,27,0,0,0},
{13,13,13,13,13,13,13,13,13,13,13,13,13,13,13,13,13,13,13,13,13,13,13,12,12,12,12,12,12,12,12,12,12,12,12,12,12,12,12,12,12,12,11,11,11,11,11,11,11,11,11,11,10,10,10,10,10,10,9,9,9,8,8,4,0,20,24,24,25,25,25,26,26,26,26,26,26,27,27,27,27,27,27,27,27,27,27,28,28,28,28,28,28,28,28,28,28,28,28,28,28,28,28,28,28,28,29,29,29,29,29,29,29,29,29,29,29,29,29,29,29,29,29,29,29,29,29,29,29,0,0,0},
{15,15,15,15,15,15,15,15,15,15,15,15,15,15,15,15,15,15,15,15,15,15,15,15,15,15,15,15,15,15,14,14,14,14,14,14,14,14,14,14,14,14,14,14,14,13,13,13,13,13,13,13,13,13,12,12,12,12,12,11,11,10,10,9,0,25,26,26,27,27,28,28,28,28,28,29,29,29,29,29,29,29,29,29,30,30,30,30,30,30,30,30,30,30,30,30,30,30,30,31,31,31,31,31,31,31,31,31,31,31,31,31,31,31,31,31,31,31,31,31,31,31,31,31,31,31,31,31,31,0,0,0}};

struct Frame {
    LAS unsigned char* lds;
    unsigned char* ldsg;
    volatile LAS unsigned* MISC;
    gu32* ctl;
    int tid, lane, wave;
    int vcu, G, bx;
    float* out; unsigned char* ws;
};
#define WSP(F, type, off) ((type*)((F).ws + (off)))
template <int I> __device__ __forceinline__ const float* arg_in() {
    const auto kp = __builtin_amdgcn_kernarg_segment_ptr(); unsigned long long p;
    asm volatile("s_load_dwordx2 %0, %1, %2\n\ts_waitcnt lgkmcnt(0)" : "=s"(p) : "s"(kp), "n"(I * 8));
    return (const float*)(const GAS float*)p;
}
#define ARG_IN(i) (arg_in<i>())

__device__ __forceinline__ int src_col(int kind, int n) {
    if (kind == 1) { if (n < 3072) return n; if (n < 3328) return 3096 + (n - 3072); if (n < 3352) return 3072 + (n - 3328); return -1; }
    if (kind == 2) { const int t = n >> 8, h = (n >> 7) & 1, c = n & 127; return h * DFF + 128 * t + c; }
    return n;
}
__device__ __forceinline__ void transpose_w(Frame& F, const float* W, int K, int Nsrc, bf16* WT, int Ndst, int kind) {
    float* scr = (float*)(F.ldsg + F.wave * 16384);
    const int gw = F.vcu * NWAVES + F.wave, NGW = F.G * NWAVES, lane = F.lane;
    const int nblk = Ndst / 32, nitems = (K / 64) * nblk;
    for (int it = gw; it < nitems; it += NGW) {
        const int kb = it / nblk, nb = it % nblk, k0 = 64 * kb, n0 = 32 * nb;
        const int sc = src_col(kind, n0 + (lane & 31));
#pragma unroll 8
        for (int i = 0; i < 32; ++i) { const int kk = 2 * i + (lane >> 5); scr[kk * 33 + (lane & 31)] = sc >= 0 ? gld<float>(W + (size_t)(k0 + kk) * Nsrc + sc) : 0.f; }
        LDS_WAIT(); asm volatile("" ::: "memory");
        const int c = lane & 7;
#pragma unroll
        for (int j = 0; j < 4; ++j) { const int n = (lane >> 3) + 8 * j; const float* s = scr + (8 * c) * 33 + n;
            v4u o; o.x = pk2(s[0 * 33], s[1 * 33]); o.y = pk2(s[2 * 33], s[3 * 33]); o.z = pk2(s[4 * 33], s[5 * 33]); o.w = pk2(s[6 * 33], s[7 * 33]);
            gst<v4u>(WT + (size_t)(n0 + n) * K + k0 + 8 * c, o); }
        LDS_WAIT(); asm volatile("" ::: "memory");
    }
}
__device__ __forceinline__ void rms_rows_bf16(Frame& F, const float* src, const float* gain, bf16* dst, int nrows) {
    const int gw = F.vcu * NWAVES + F.wave, NGW = F.G * NWAVES, lane = F.lane;
    for (int m = gw; m < nrows; m += NGW) {
        const f32x4* xr = (const f32x4*)(src + (size_t)m * D) + lane; const f32x4* gr = (const f32x4*)gain + lane;
        f32x4 v[4]; float s = 0.f;
#pragma unroll
        for (int j = 0; j < 4; ++j) { v[j] = gld<f32x4>(xr + 64 * j); s += (v[j].x * v[j].x + v[j].y * v[j].y) + (v[j].z * v[j].z + v[j].w * v[j].w); }
        const float r = 1.0f / sqrtf(wave_sum(s) * (1.f / D) + EPS);
        v2u* o8 = (v2u*)(dst + (size_t)m * D) + lane;
#pragma unroll
        for (int j = 0; j < 4; ++j) { const f32x4 g = gld<f32x4>(gr + 64 * j); v2u w; w.x = pk2(v[j].x * r * g.x, v[j].y * r * g.y); w.y = pk2(v[j].z * r * g.z, v[j].w * r * g.w); gst<v2u>(o8 + 64 * j, w); }
    }
}
__device__ __forceinline__ void row_pass(Frame& F, const float* xold, const float* Y, const float* g_post, float* xnew, const float* g_pre, bf16* xn) {
    const int gw = F.vcu * NWAVES + F.wave, NGW = F.G * NWAVES, lane = F.lane;
    for (int m = gw; m < T; m += NGW) {
        const f32x4* yr = (const f32x4*)(Y + (size_t)m * D) + lane; const f32x4* xr = (const f32x4*)(xold + (size_t)m * D) + lane;
        f32x4 y[4], x[4]; float s = 0.f;
#pragma unroll
        for (int j = 0; j < 4; ++j) { y[j] = gld<f32x4>(yr + 64 * j); x[j] = gld<f32x4>(xr + 64 * j); s += (y[j].x * y[j].x + y[j].y * y[j].y) + (y[j].z * y[j].z + y[j].w * y[j].w); }
        const float r = 1.0f / sqrtf(wave_sum(s) * (1.f / D) + EPS);
        f32x4* xo = (f32x4*)(xnew + (size_t)m * D) + lane; float s2 = 0.f;
#pragma unroll
        for (int j = 0; j < 4; ++j) { const f32x4 g = gld<f32x4>((const f32x4*)g_post + lane + 64 * j); x[j] = x[j] + y[j] * r * g; gst<f32x4>(xo + 64 * j, x[j]);
            s2 += (x[j].x * x[j].x + x[j].y * x[j].y) + (x[j].z * x[j].z + x[j].w * x[j].w); }
        if (g_pre) {
            const float r2 = 1.0f / sqrtf(wave_sum(s2) * (1.f / D) + EPS);
            v2u* o8 = (v2u*)(xn + (size_t)m * D) + lane;
#pragma unroll
            for (int j = 0; j < 4; ++j) { const f32x4 g = gld<f32x4>((const f32x4*)g_pre + lane + 64 * j); v2u w; w.x = pk2(x[j].x * r2 * g.x, x[j].y * r2 * g.y); w.y = pk2(x[j].z * r2 * g.z, x[j].w * r2 * g.w); gst<v2u>(o8 + 64 * j, w); }
        }
    }
}

__device__ __forceinline__ void attn_band_naive(Frame& F) {
    const int gw = F.vcu * NWAVES + F.wave, NGW = F.G * NWAVES, lane = F.lane;
    const bf16* PR = WSP(F, const bf16, WS_BIG); bf16* MIX = WSP(F, bf16, WS_MIX); float* LSE = WSP(F, float, WS_LSE);
    const float* rel_bias = ARG_IN(2);
    for (int task = gw; task < T * NHEAD_A; task += NGW) {
        const int t = task / NHEAD_A, head = task % NHEAD_A, g = head >> 2, dil = 1 << (2 * g), b = t >> 12, s = t & (SEQ - 1);
        const float qv = bf2f(PR[(size_t)t * ATT_IN + head * 64 + lane]);
        float lg[3]; bool val[3];
#pragma unroll
        for (int pass = 0; pass < 3; ++pass) {
            const int ji = lane + 64 * pass, pos = s + (ji - 64) * dil; const bool valid = (ji <= 128) && pos >= 0 && pos < SEQ;
            const bf16* krow = PR + (size_t)(b * SEQ + (valid ? pos : s)) * ATT_IN + TOKW + head * 64;
            float dot = 0.f;
#pragma unroll
            for (int d8 = 0; d8 < 8; ++d8) { const v4u kk = *(const v4u*)(krow + 8 * d8);
                dot += bflo(kk.x) * __shfl(qv, 8 * d8 + 0) + bfhi(kk.x) * __shfl(qv, 8 * d8 + 1) + bflo(kk.y) * __shfl(qv, 8 * d8 + 2) + bfhi(kk.y) * __shfl(qv, 8 * d8 + 3)
                     + bflo(kk.z) * __shfl(qv, 8 * d8 + 4) + bfhi(kk.z) * __shfl(qv, 8 * d8 + 5) + bflo(kk.w) * __shfl(qv, 8 * d8 + 6) + bfhi(kk.w) * __shfl(qv, 8 * d8 + 7); }
            const int jc = ji <= 128 ? ji : 128;
            lg[pass] = valid ? dot * 0.125f + rel_bias[(int)BUCKET[g][jc] * NHEAD_A + head] : -1e30f; val[pass] = valid;
        }
        const float mx = wave_max(fmaxf(fmaxf(lg[0], lg[1]), lg[2]));
        float p[3];
#pragma unroll
        for (int pass = 0; pass < 3; ++pass) p[pass] = val[pass] ? __expf(lg[pass] - mx) : 0.f;
        const float den = wave_sum(p[0] + p[1] + p[2]);
        float o = 0.f;
        const bf16* vbase = PR + (size_t)(b * SEQ) * ATT_IN + 2 * TOKW + head * 64 + lane;
        for (int ji = 0; ji < 129; ++ji) {
            const int pos = s + (ji - 64) * dil; if (pos < 0 || pos >= SEQ) continue;
            const float pj = __shfl(ji < 64 ? p[0] : (ji < 128 ? p[1] : p[2]), ji & 63);
            o += pj * bf2f(vbase[(size_t)pos * ATT_IN]);
        }
        MIX[(size_t)t * D + head * 64 + lane] = (bf16)f2bf(o / den);
        if (lane == 0) LSE[(size_t)t * NHEAD_A + head] = mx + __logf(den);
    }
}
__device__ __forceinline__ void attn_mem_naive(Frame& F, const bf16* qsrc, int qpitch, const bf16* KV, int vb, int nvb) {
    const int gw = vb * NWAVES + F.wave, NGW = nvb * NWAVES, lane = F.lane;
    bf16* MIX = WSP(F, bf16, WS_MIX);
    for (int task = gw; task < T * 4; task += NGW) {
        const int t = task >> 2, mh = task & 3, b = t >> 12;
        const float qv = bf2f(qsrc[(size_t)t * qpitch + mh * 64 + lane]);
        float lg[4];
#pragma unroll
        for (int pass = 0; pass < 4; ++pass) {
            const bf16* krow = KV + (size_t)(b * MEML + lane + 64 * pass) * 512 + mh * 64;
            float dot = 0.f;
#pragma unroll
            for (int d8 = 0; d8 < 8; ++d8) { const v4u kk = *(const v4u*)(krow + 8 * d8);
                dot += bflo(kk.x) * __shfl(qv, 8 * d8 + 0) + bfhi(kk.x) * __shfl(qv, 8 * d8 + 1) + bflo(kk.y) * __shfl(qv, 8 * d8 + 2) + bfhi(kk.y) * __shfl(qv, 8 * d8 + 3)
                     + bflo(kk.z) * __shfl(qv, 8 * d8 + 4) + bfhi(kk.z) * __shfl(qv, 8 * d8 + 5) + bflo(kk.w) * __shfl(qv, 8 * d8 + 6) + bfhi(kk.w) * __shfl(qv, 8 * d8 + 7); }
            lg[pass] = dot * 0.125f;
        }
        const float mx = wave_max(fmaxf(fmaxf(lg[0], lg[1]), fmaxf(lg[2], lg[3])));
        float p[4];
#pragma unroll
        for (int pass = 0; pass < 4; ++pass) p[pass] = __expf(lg[pass] - mx);
        const float den = wave_sum((p[0] + p[1]) + (p[2] + p[3]));
        float o = 0.f;
        const bf16* vbase = KV + (size_t)(b * MEML) * 512 + 256 + mh * 64 + lane;
        for (int m = 0; m < MEML; ++m) {
            const float pj = __shfl(m < 64 ? p[0] : (m < 128 ? p[1] : (m < 192 ? p[2] : p[3])), m & 63);
            o += pj * bf2f(vbase[(size_t)m * 512]);
        }
        MIX[(size_t)t * D + TOKW + mh * 64 + lane] = (bf16)f2bf(o / den);
    }
}
typedef short bf16x8v __attribute__((ext_vector_type(8)));
typedef short s4v __attribute__((ext_vector_type(4)));
constexpr int AT_STRIDE = 160;
constexpr int AT_K = 0, AT_V = 256 * AT_STRIDE, AT_BIAS = 2 * 256 * AT_STRIDE;
struct AttnUnit {
    const bf16* qsrc; int qpitch, qcol, tbase, tstep;
    const bf16* ksrc; int kpitch, kcol, vcol, kbase, kstep, koff, kmax;
    int ocol, head, grp, L, m0;
};
template <int NT, bool BAND>
__device__ __forceinline__ void attn_unit_fast(Frame& F, const AttnUnit& U) {
    const int tid = F.tid, lane = F.lane, w = F.wave, q = lane & 15, g = lane >> 4;
    LAS unsigned char* Kl = F.lds + AT_K; LAS unsigned char* Vl = F.lds + AT_V; LAS float* bias = (LAS float*)(F.lds + AT_BIAS);
    bf16* MIX = WSP(F, bf16, WS_MIX);
    __syncthreads();
    {
        v4u kv[4], vv[4];
#pragma unroll
        for (int i = 0; i < 4; ++i) { const int row = (tid >> 3) + 64 * i; int kr = row + U.koff; kr = kr < 0 ? 0 : (kr > U.kmax ? U.kmax : kr);
            const bf16* p = U.ksrc + (size_t)(U.kbase + kr * U.kstep) * U.kpitch + (tid & 7) * 8;
            kv[i] = gld<v4u>(p + U.kcol); vv[i] = gld<v4u>(p + U.vcol); }
#pragma unroll
        for (int i = 0; i < 4; ++i) { const int off = ((tid >> 3) + 64 * i) * AT_STRIDE + (tid & 7) * 16;
            *(LAS v4u*)(Kl + off) = kv[i]; *(LAS v4u*)(Vl + off) = vv[i]; }
        if (BAND && tid < 129) bias[tid] = gld<float>(ARG_IN(2) + (int)BUCKET[U.grp][tid] * NHEAD_A + U.head);
    }
    const int tok = U.tbase + (16 * w + q) * U.tstep;
    bf16x8v qf[2];
#pragma unroll
    for (int kk = 0; kk < 2; ++kk) qf[kk] = gld<bf16x8v>(U.qsrc + (size_t)tok * U.qpitch + U.qcol + 32 * kk + 8 * g);
    __syncthreads();
    const int tb = BAND ? w : 0;
    f32x4 s[NT];
#pragma unroll
    for (int t = 0; t < NT; ++t) { s[t] = (f32x4){0.f, 0.f, 0.f, 0.f};
#pragma unroll
        for (int kk = 0; kk < 2; ++kk) { const bf16x8v a = *(const LAS bf16x8v*)(Kl + (16 * (tb + t) + q) * AT_STRIDE + (32 * kk + 8 * g) * 2);
            s[t] = __builtin_amdgcn_mfma_f32_16x16x32_bf16(a, qf[kk], s[t], 0, 0, 0); } }
    float mx = -3.0e38f;
#pragma unroll
    for (int t = 0; t < NT; ++t)
#pragma unroll
        for (int r = 0; r < 4; ++r) { float v = s[t][r] * 0.125f;
            if (BAND) { const int kl = 16 * t + 4 * g + r, ji = kl - q, m = U.m0 + 16 * w - 64 + kl; const bool ok = ji >= 0 && ji <= 128 && m >= 0 && m < U.L;
                v = ok ? v + bias[ji < 0 ? 0 : (ji > 128 ? 128 : ji)] : -1.0e30f; }
            s[t][r] = v; mx = fmaxf(mx, v); }
    mx = fmaxf(mx, __shfl_xor(mx, 16)); mx = fmaxf(mx, __shfl_xor(mx, 32));
    float den = 0.f;
#pragma unroll
    for (int t = 0; t < NT; ++t)
#pragma unroll
        for (int r = 0; r < 4; ++r) { const float p = __expf(s[t][r] - mx); s[t][r] = p; den += p; }
    den += __shfl_xor(den, 16); den += __shfl_xor(den, 32);
    f32x4 o[4];
#pragma unroll
    for (int dt = 0; dt < 4; ++dt) o[dt] = (f32x4){0.f, 0.f, 0.f, 0.f};
    constexpr int NKB = (NT + 1) / 2;
#pragma unroll
    for (int kb = 0; kb < NKB; ++kb) {
        const int ta = 2 * kb, tc = 2 * kb + 1; const bool has_c = tc < NT;
        const f32x4 pa = s[ta], pc = has_c ? s[tc < NT ? tc : 0] : (f32x4){0.f, 0.f, 0.f, 0.f};
        v4u pw; pw.x = pk2(pa[0], pa[1]); pw.y = pk2(pa[2], pa[3]); pw.z = pk2(pc[0], pc[1]); pw.w = pk2(pc[2], pc[3]);
        const bf16x8v pf = __builtin_bit_cast(bf16x8v, pw);
        int tia = tb + ta, tic = tb + tc; tic = tic > 15 ? 15 : tic;
        LAS unsigned char* ra = Vl + (16 * tia + 4 * g + (q >> 2)) * AT_STRIDE + 8 * (q & 3);
        LAS unsigned char* rc = Vl + (16 * tic + 4 * g + (q >> 2)) * AT_STRIDE + 8 * (q & 3);
#pragma unroll
        for (int dt = 0; dt < 4; ++dt) {
            const s4v va = __builtin_amdgcn_ds_read_tr16_b64_v4i16((LAS s4v*)(ra + 32 * dt)), vc = __builtin_amdgcn_ds_read_tr16_b64_v4i16((LAS s4v*)(rc + 32 * dt));
            bf16x8v af; af[0] = va[0]; af[1] = va[1]; af[2] = va[2]; af[3] = va[3]; af[4] = vc[0]; af[5] = vc[1]; af[6] = vc[2]; af[7] = vc[3];
            o[dt] = __builtin_amdgcn_mfma_f32_16x16x32_bf16(af, pf, o[dt], 0, 0, 0);
        }
    }
    const float inv = 1.0f / den;
    bf16* orow = MIX + (size_t)tok * D + U.ocol + 4 * g;
#pragma unroll
    for (int dt = 0; dt < 4; ++dt) { v2u wv; wv.x = pk2(o[dt][0] * inv, o[dt][1] * inv); wv.y = pk2(o[dt][2] * inv, o[dt][3] * inv); gst<v2u>(orow + 16 * dt, wv); }
    if (BAND && g == 0) gst<float>(WSP(F, float, WS_LSE) + (size_t)tok * NHEAD_A + U.head, mx + __logf(den));
}
__device__ __forceinline__ void attn_phase_fast(Frame& F, bool mem_only, int vb, int nvb) {
    const bf16* PR = WSP(F, const bf16, WS_BIG); const bf16* MIXc = WSP(F, const bf16, WS_MIX);
    const int nband = mem_only ? 0 : NB * NHEAD_A * 32, ntot = nband + NB * 4 * 32;
#pragma unroll 1
    for (int u = vb; u < ntot; u += nvb) {
        AttnUnit U;
        if (u < nband) {
            const int blk = u & 31, head = (u >> 5) % NHEAD_A, b = u / (32 * NHEAD_A), grp = head >> 2, dil = 1 << (2 * grp), L = SEQ / dil, bpc = L / 128, r = blk / bpc, m0 = (blk % bpc) * 128;
            U.qsrc = PR; U.qpitch = ATT_IN; U.qcol = head * 64; U.tbase = b * SEQ + r + dil * m0; U.tstep = dil;
            U.ksrc = PR; U.kpitch = ATT_IN; U.kcol = TOKW + head * 64; U.vcol = 2 * TOKW + head * 64; U.kbase = b * SEQ + r; U.kstep = dil; U.koff = m0 - 64; U.kmax = L - 1;
            U.ocol = head * 64; U.head = head; U.grp = grp; U.L = L; U.m0 = m0;
            attn_unit_fast<9, true>(F, U);
        } else {
            const int v = u - nband, blk = v & 31, mh = (v >> 5) & 3, b = v >> 7;
            U.qsrc = mem_only ? MIXc : PR; U.qpitch = mem_only ? D : ATT_IN; U.qcol = (mem_only ? TOKW : 3 * TOKW) + mh * 64; U.tbase = b * SEQ + blk * 128; U.tstep = 1;
            U.ksrc = WSP(F, const bf16, WS_MEMKV) + (mem_only ? (size_t)NB * MEML * 512 : 0); U.kpitch = 512; U.kcol = mh * 64; U.vcol = 256 + mh * 64; U.kbase = b * MEML; U.kstep = 1; U.koff = 0; U.kmax = MEML - 1;
            U.ocol = TOKW + mh * 64; U.head = 0; U.grp = 0; U.L = MEML; U.m0 = 0;
            attn_unit_fast<16, false>(F, U);
        }
    }
}

__device__ __forceinline__ void lse_mix(Frame& F) {
    const int gw = F.vcu * NWAVES + F.wave, NGW = F.G * NWAVES, lane = F.lane;
    bf16* MIX = WSP(F, bf16, WS_MIX); const float* LSE = WSP(F, const float, WS_LSE);
    for (int t = gw; t < T; t += NGW) {
        float w[12];
#pragma unroll
        for (int j = 0; j < 4; ++j) { const float l0 = gld<float>(LSE + (size_t)t * 12 + j), l1 = gld<float>(LSE + (size_t)t * 12 + 4 + j), l2 = gld<float>(LSE + (size_t)t * 12 + 8 + j);
            const float mx = fmaxf(l0, fmaxf(l1, l2)); const float e0 = __expf(l0 - mx), e1 = __expf(l1 - mx), e2 = __expf(l2 - mx), inv = 1.0f / (e0 + e1 + e2);
            w[j] = e0 * inv; w[4 + j] = e1 * inv; w[8 + j] = e2 * inv; }
        bf16* row = MIX + (size_t)t * D + lane;
#pragma unroll
        for (int h = 0; h < 12; ++h) gst<bf16>(row + 64 * h, (bf16)f2bf(bf2f(gld<bf16>(row + 64 * h)) * w[h]));
    }
}

__device__ __forceinline__ void dn_naive(Frame& F, int chain) {
    const int b = chain / 12, h = (chain >> 1) % 6, dir = chain & 1, tid = F.tid, lane = F.lane, wave = F.wave;
    const bf16* P = WSP(F, const bf16, WS_BIG); const float* GATE = WSP(F, const float, WS_GATE); float* O = WSP(F, float, WS_Y);
    const float* conv_w = ARG_IN(6); const float a_neg = -__expf(ARG_IN(7)[dir * 6 + h]); const float dtb = ARG_IN(8)[dir * 6 + h];
    float* qs = (float*)F.ldsg; float* ks = qs + 64 * 128; float* vs = ks + 64 * 128; float* gl = vs + 64 * 128; float* bl = gl + 64;
    float S[128];
#pragma unroll
    for (int i = 0; i < 128; ++i) S[i] = 0.f;
    for (int cc = 0; cc < NCHUNK; ++cc) {
        const int c = dir ? (NCHUNK - 1 - cc) : cc; const int s0 = c * CH; const size_t t0 = (size_t)b * SEQ + s0;
        __syncthreads();
        for (int idx = tid; idx < 64 * 384; idx += NWAVES * 64) {
            const int tok = idx / 384, ch = idx % 384, which = ch >> 7, d = ch & 127, col = which * TOKW + h * DNH + d;
            float acc = 0.f;
#pragma unroll
            for (int k = 0; k < 5; ++k) { const int s = s0 + tok + k - 2; if (s >= 0 && s < SEQ) acc += bf2f(P[((size_t)b * SEQ + s) * 2304 + col]) * conv_w[k * 2304 + col]; }
            qs[which * 8192 + tok * 128 + d] = silu(acc);
        }
        if (tid < 64) { const size_t t = t0 + tid; const float gi = GATE[t * 24 + dir * 12 + h] + dtb, bi = GATE[t * 24 + dir * 12 + 6 + h];
            const float sp = gi > 20.f ? gi : log1pf(__expf(gi)); gl[tid] = a_neg * sp; bl[tid] = 1.0f / (1.0f + __expf(-bi)); }
        __syncthreads();
#pragma unroll 1
        for (int i = 0; i < 8; ++i) { const int tok = wave * 8 + i;
            const float q0 = qs[tok * 128 + lane], q1 = qs[tok * 128 + 64 + lane], k0 = ks[tok * 128 + lane], k1 = ks[tok * 128 + 64 + lane];
            const float rq = 0.08838834764831845f / sqrtf(wave_sum(q0 * q0 + q1 * q1) + EPS), rk = 1.0f / sqrtf(wave_sum(k0 * k0 + k1 * k1) + EPS);
            qs[tok * 128 + lane] = q0 * rq; qs[tok * 128 + 64 + lane] = q1 * rq; ks[tok * 128 + lane] = k0 * rk; ks[tok * 128 + 64 + lane] = k1 * rk; }
        __syncthreads();
        if (tid < 128) {
            const int j = tid;
#pragma unroll 1
            for (int i = 0; i < CH; ++i) {
                const int p = dir ? (CH - 1 - i) : i;
                const float eg = __expf(gl[p]), bt = bl[p], vj = vs[p * 128 + j];
                const f32x4* kp = (const f32x4*)(ks + p * 128); const f32x4* qp = (const f32x4*)(qs + p * 128);
                float r0 = 0.f, r1 = 0.f, r2 = 0.f, r3 = 0.f;
#pragma unroll
                for (int i4 = 0; i4 < 32; ++i4) { const f32x4 kv = kp[i4]; r0 += kv.x * S[4 * i4]; r1 += kv.y * S[4 * i4 + 1]; r2 += kv.z * S[4 * i4 + 2]; r3 += kv.w * S[4 * i4 + 3]; if ((i4 & 3) == 3) asm volatile("" ::: "memory"); }
                const float r = (r0 + r1) + (r2 + r3);
                const float c1 = bt * (vj - eg * r);
                float o0 = 0.f, o1 = 0.f, o2 = 0.f, o3 = 0.f;
#pragma unroll
                for (int i4 = 0; i4 < 32; ++i4) { const f32x4 kv = kp[i4], qv = qp[i4];
                    S[4 * i4] = eg * S[4 * i4] + kv.x * c1; S[4 * i4 + 1] = eg * S[4 * i4 + 1] + kv.y * c1; S[4 * i4 + 2] = eg * S[4 * i4 + 2] + kv.z * c1; S[4 * i4 + 3] = eg * S[4 * i4 + 3] + kv.w * c1;
                    o0 += qv.x * S[4 * i4]; o1 += qv.y * S[4 * i4 + 1]; o2 += qv.z * S[4 * i4 + 2]; o3 += qv.w * S[4 * i4 + 3]; if ((i4 & 3) == 3) asm volatile("" ::: "memory"); }
                atomicAdd(O + (t0 + p) * TOKW + h * DNH + j, (o0 + o1) + (o2 + o3));
            }
        }
    }
}
constexpr size_t WS_QKVC = WS_XN;
constexpr size_t WS_TB = WS_XN + 144 * MiB;
constexpr size_t WS_TBW = WS_BIG + 96 * MiB;
constexpr size_t WS_OF = WS_BIG, WS_OB = WS_BIG + (size_t)T * TOKW * 2;
static_assert(WS_TB + 48 * MiB <= WS_BIG && WS_XN + 64 * MiB == WS_Y, "delta-net workspace overlay");
constexpr int DQ = 0, DQ_S = 288, DK = 18432, DK_S = 288, DV = 36864, DV_S = 288, DW = 55296, DW_S = 288, DI = 73728, DI_S = 160, DT = 83968, DT_S = 160, DTW = 94208, DG = 104448;
constexpr int DA_KK = 36864, DA_L = 53760, DA_G = 86528;
__device__ __forceinline__ int pperm(int x) { return x < 16 ? 8 * (x >> 2) + (x & 3) : 8 * ((x - 16) >> 2) + 4 + (x & 3); }
__device__ __forceinline__ bf16x8v frag_row(LAS unsigned char* base, int row, int stride, int cb, int g) { return *(const LAS bf16x8v*)(base + row * stride + (cb + 8 * g) * 2); }
#define LDS_BARRIER() do { asm volatile("s_waitcnt lgkmcnt(0)" ::: "memory"); __builtin_amdgcn_s_barrier(); asm volatile("" ::: "memory"); } while (0)
__device__ __forceinline__ bf16x8v mk_frag(v2u lo, v2u hi) { v4u w; w.x = lo.x; w.y = lo.y; w.z = hi.x; w.w = hi.y; return __builtin_bit_cast(bf16x8v, w); }
__device__ __forceinline__ bf16x8v frag_k2(LAS unsigned char* base, int row, int stride, int cb, int g) {
    LAS unsigned char* p = base + row * stride + (cb + 4 * g) * 2; return mk_frag(*(LAS v2u*)p, *(LAS v2u*)(p + 32)); }
__device__ __forceinline__ bf16x8v frag_tr(LAS unsigned char* base, int stride, int rb, int col0, int i, int g) {
    LAS unsigned char* p = base + (rb + 4 * g + (i >> 2)) * stride + (col0 + 4 * (i & 3)) * 2;
    const s4v a = __builtin_amdgcn_ds_read_tr16_b64_v4i16((LAS s4v*)p), c = __builtin_amdgcn_ds_read_tr16_b64_v4i16((LAS s4v*)(p + 16 * stride));
    bf16x8v f; f[0] = a[0]; f[1] = a[1]; f[2] = a[2]; f[3] = a[3]; f[4] = c[0]; f[5] = c[1]; f[6] = c[2]; f[7] = c[3]; return f; }
__device__ __forceinline__ bf16x8v frag_acc(f32x4 a, f32x4 c) { v4u w; w.x = pk2(a[0], a[1]); w.y = pk2(a[2], a[3]); w.z = pk2(c[0], c[1]); w.w = pk2(c[2], c[3]); return __builtin_bit_cast(bf16x8v, w); }
__device__ __forceinline__ bf16x8v scale_frag(v4u raw, f32x4 slo, f32x4 shi) { v4u w;
    w.x = pk2(bflo(raw.x) * slo[0], bfhi(raw.x) * slo[1]); w.y = pk2(bflo(raw.y) * slo[2], bfhi(raw.y) * slo[3]);
    w.z = pk2(bflo(raw.z) * shi[0], bfhi(raw.z) * shi[1]); w.w = pk2(bflo(raw.w) * shi[2], bfhi(raw.w) * shi[3]); return __builtin_bit_cast(bf16x8v, w); }
__device__ __forceinline__ void conv4x4(const bf16* P, const float* cw, int b, int s, int col0, float (&out)[4][4]) {
    float x[8][4];
#pragma unroll
    for (int rr = 0; rr < 8; ++rr) { const int sr = s - 2 + rr; v2u w = (v2u){0u, 0u};
        if (sr >= 0 && sr < SEQ) w = gld<v2u>(P + ((size_t)b * SEQ + sr) * 2304 + col0);
        x[rr][0] = bflo(w.x); x[rr][1] = bfhi(w.x); x[rr][2] = bflo(w.y); x[rr][3] = bfhi(w.y); }
    f32x4 c[5];
#pragma unroll
    for (int k = 0; k < 5; ++k) c[k] = gld<f32x4>(cw + k * 2304 + col0);
#pragma unroll
    for (int tt = 0; tt < 4; ++tt)
#pragma unroll
        for (int e = 0; e < 4; ++e) { float a = 0.f;
#pragma unroll
            for (int k = 0; k < 5; ++k) a += x[tt + k][e] * c[k][e];
            out[tt][e] = silu(a); }
}
__device__ __forceinline__ float hw_sum32(float v) { v += __shfl_xor(v, 1); v += __shfl_xor(v, 2); v += __shfl_xor(v, 4); v += __shfl_xor(v, 8); v += __shfl_xor(v, 16); return v; }
__device__ __forceinline__ void dn_gates(Frame& F, int b, int h, int c, int dir, int lane, float& beta, float& cs) {
    const float* GATE = WSP(F, const float, WS_GATE);
    const size_t t = (size_t)b * SEQ + c * CH + lane;
    const float gi = gld<float>(GATE + t * 24 + dir * 12 + h) + gld<float>(ARG_IN(8) + dir * 6 + h), bi = gld<float>(GATE + t * 24 + dir * 12 + 6 + h);
    const float sp = gi > 20.f ? gi : log1pf(__expf(gi));
    cs = -__expf(gld<float>(ARG_IN(7) + dir * 6 + h)) * sp; beta = 1.0f / (1.0f + __expf(-bi));
#pragma unroll
    for (int o = 1; o < 64; o <<= 1) { const float up = __shfl_up(cs, o), dn = __shfl_down(cs, o); if (dir == 0) { if (lane >= o) cs += up; } else { if (lane + o < 64) cs += dn; } }
}
__device__ __forceinline__ void dn_prep(Frame& F) {
    const int lane = F.lane, cg = lane & 31;
    const bf16* P = WSP(F, const bf16, WS_BIG); bf16* QC = WSP(F, bf16, WS_QKVC); float* G2 = WSP(F, float, WS_G2);
    const int ghw = (F.vcu * NWAVES + F.wave) * 2 + (lane >> 5), NHW = F.G * NWAVES * 2;
#pragma unroll 1
    for (int task = ghw; task < NB * 64 * 18 * 16; task += NHW) {
        const int tg = task & 15, ht = (task >> 4) % 18, bc = task / 288, c = bc & 63, b = bc >> 6, which = ht / 6, h = ht % 6, col0 = which * TOKW + h * DNH + 4 * cg;
        float o[4][4]; conv4x4(P, ARG_IN(6), b, c * CH + 4 * tg, col0, o);
#pragma unroll
        for (int tt = 0; tt < 4; ++tt) { float r = 1.0f;
            const float ss = hw_sum32((o[tt][0] * o[tt][0] + o[tt][1] * o[tt][1]) + (o[tt][2] * o[tt][2] + o[tt][3] * o[tt][3]));
            if (which < 2) r = (which == 0 ? 0.08838834764831845f : 1.0f) / sqrtf(ss + EPS);
            v2u wv; wv.x = pk2(o[tt][0] * r, o[tt][1] * r); wv.y = pk2(o[tt][2] * r, o[tt][3] * r);
            gst<v2u>(QC + ((size_t)b * SEQ + c * CH + 4 * tg + tt) * 2304 + col0, wv); }
    }
    const int gw = F.vcu * NWAVES + F.wave, NGW = F.G * NWAVES;
#pragma unroll 1
    for (int task = gw; task < NB * NHEAD_D * NCHUNK * 2; task += NGW) {
        const int dir = task & 1, unit = task >> 1, c = unit & 63, h = (unit >> 6) % NHEAD_D, b = unit / (64 * NHEAD_D);
        float beta, cs; dn_gates(F, b, h, c, dir, lane, beta, cs);
        gst<float>(G2 + (size_t)task * 128 + lane, cs); gst<float>(G2 + (size_t)task * 128 + 64 + lane, beta);
    }
}
__host__ __device__ constexpr int ts_roff(int i) { return i == 0 ? 0 : 8 * ((i - 1) >> 2) * (((i - 1) >> 2) + 1) + 4 * ((i - 1) & 3) * (((i - 1) >> 2) + 1); }
constexpr int TS_K = 0, TS_KB = 18432, TS_L = 4 * TS_KB, TS_LB = ts_roff(64) * 4, TS_G = TS_L + 8 * TS_LB, TS_END = TS_G + 4 * 1024;
static_assert(TS_LB == 8448 && TS_END <= LDSCTL_OFF, "tsolve LDS map");
__device__ __forceinline__ void dn_tsolve_group(Frame& F, int grp) {
    int tid_ = F.tid; asm volatile("" : "+v"(tid_));
    const int tid = tid_, lane = tid & 63, w = F.wave, i = lane & 15, g = lane >> 4, p = w >> 1, wh = w & 1, unit = 4 * grp + p;
    const int c = unit & 63, h = (unit >> 6) % NHEAD_D, b = unit / (64 * NHEAD_D);
    LAS unsigned char* Kl = F.lds + TS_K + p * TS_KB; LAS float* Gl = (LAS float*)(F.lds + TS_G + p * 1024);
    LAS float* Lf = (LAS float*)(F.lds + TS_L + (2 * p) * TS_LB); LAS float* Lb = (LAS float*)(F.lds + TS_L + (2 * p + 1) * TS_LB);
    __syncthreads();
    {   const bf16* kc = WSP(F, const bf16, WS_QKVC) + ((size_t)b * SEQ + c * CH) * 2304 + TOKW + h * DNH; const int pt = tid & 127;
#pragma unroll
        for (int r8 = 0; r8 < 8; ++r8) { const int id = pt + 128 * r8, row = id >> 4, ch = id & 15; *(LAS v4u*)(Kl + row * DK_S + ch * 16) = gld<v4u>(kc + (size_t)row * 2304 + ch * 8); }
        const float* g2 = WSP(F, const float, WS_G2) + ((size_t)unit * 2 + wh) * 128; Gl[wh * 128 + lane] = gld<float>(g2 + lane); Gl[wh * 128 + 64 + lane] = gld<float>(g2 + 64 + lane);
    }
    __syncthreads();
#pragma unroll 1
    for (int tt = 0; tt < 8; ++tt) { const int it = 2 * wh + (tt >> 2), jt = tt & 3; f32x4 acc = (f32x4){0.f, 0.f, 0.f, 0.f};
#pragma unroll
        for (int ks = 0; ks < 4; ++ks) { const bf16x8v a = *(const LAS bf16x8v*)(Kl + (16 * it + i) * DK_S + (32 * ks + 8 * g) * 2), bb = *(const LAS bf16x8v*)(Kl + (16 * jt + i) * DK_S + (32 * ks + 8 * g) * 2);
            acc = __builtin_amdgcn_mfma_f32_16x16x32_bf16(a, bb, acc, 0, 0, 0); }
        const int C = 16 * jt + i; const float gfC = Gl[C], gbC = Gl[128 + C];
#pragma unroll
        for (int r = 0; r < 4; ++r) { const int R = 16 * it + 4 * g + r;
            if (C < R) Lf[ts_roff(R) + C] = Gl[64 + R] * acc[r] * __expf(Gl[R] - gfC);
            if (C > R) Lb[ts_roff(63 - R) + (63 - C)] = Gl[192 + R] * acc[r] * __expf(Gl[128 + R] - gbC); } }
    __syncthreads();
    {   const int dir = wh; LAS float* Lw = dir ? Lb : Lf; float Tc[64];
#pragma unroll
        for (int ii = 0; ii < 64; ++ii) { float a0 = (lane == ii) ? 1.f : 0.f, a1 = 0.f;
#pragma unroll
            for (int j4 = 0; j4 < (ii + 3) / 4; ++j4) { const f32x4 l = *(const LAS f32x4*)(Lw + ts_roff(ii) + 4 * j4);
                if (4 * j4 + 0 < ii) a0 -= l[0] * Tc[4 * j4 + 0]; if (4 * j4 + 1 < ii) a1 -= l[1] * Tc[4 * j4 + 1];
                if (4 * j4 + 2 < ii) a0 -= l[2] * Tc[4 * j4 + 2]; if (4 * j4 + 3 < ii) a1 -= l[3] * Tc[4 * j4 + 3]; }
            Tc[ii] = a0 + a1; }
        const int pc = dir ? 63 - lane : lane; const float bc = Gl[dir * 128 + 64 + pc], bwc = bc * __expf(Gl[dir * 128 + pc]);
        bf16* TU = WSP(F, bf16, WS_TB) + ((size_t)unit * 2 + dir) * 4096 + pc; bf16* TW = WSP(F, bf16, WS_TBW) + ((size_t)unit * 2 + dir) * 4096 + pc;
        if (dir == 0) {
#pragma unroll
            for (int ii = 0; ii < 64; ++ii) { const unsigned pk = pk2(Tc[ii] * bc, Tc[ii] * bwc); gst<bf16>(TU + ii * 64, (bf16)(pk & 0xffffu)); gst<bf16>(TW + ii * 64, (bf16)(pk >> 16)); }
        } else {
#pragma unroll
            for (int ii = 0; ii < 64; ++ii) { const unsigned pk = pk2(Tc[ii] * bc, Tc[ii] * bwc); gst<bf16>(TU + (63 - ii) * 64, (bf16)(pk & 0xffffu)); gst<bf16>(TW + (63 - ii) * 64, (bf16)(pk >> 16)); }
        }
    }
}
template <int VAR> __device__ __forceinline__ void dn_scan(Frame& F, int chain) {
    const int b = chain / 12, h = (chain >> 1) % NHEAD_D, dir = chain & 1;
    int tid_ = F.tid; asm volatile("" : "+v"(tid_));
    const int tid = tid_, lane = tid & 63, w = F.wave, i = lane & 15, g = lane >> 4;
    const bf16* QC = WSP(F, const bf16, WS_QKVC); const bf16* TB = WSP(F, const bf16, WS_TB); const bf16* TBW = WSP(F, const bf16, WS_TBW); const float* G2 = WSP(F, const float, WS_G2); bf16* OD = WSP(F, bf16, dir ? WS_OB : WS_OF);
    LAS unsigned char* Ql = F.lds + DQ; LAS unsigned char* Kl = F.lds + DK; LAS unsigned char* Vl = F.lds + DV; LAS unsigned char* Wl = F.lds + DW; LAS unsigned char* Il = F.lds + DI; LAS unsigned char* Tl = F.lds + DT; LAS unsigned char* Twl = F.lds + DTW;
    LAS float* Gl = (LAS float*)(F.lds + DG);
    f32x4 Sacc[8];
#pragma unroll
    for (int kt = 0; kt < 8; ++kt) Sacc[kt] = (f32x4){0.f, 0.f, 0.f, 0.f};
    v4u pf[3][2], pfT, pfTw; float pg0 = 0.f, pg1 = 0.f;
#define DN_PREFETCH(cidx) do { const int c_ = (cidx); const size_t unit_ = (size_t)(b * NHEAD_D + h) * 64 + c_; const bf16* src_ = QC + ((size_t)b * SEQ + c_ * CH) * 2304 + h * DNH; \
        _Pragma("unroll") for (int x_ = 0; x_ < 3; ++x_) _Pragma("unroll") for (int r_ = 0; r_ < 2; ++r_) { const int id_ = tid + 512 * r_; pf[x_][r_] = gld<v4u>(src_ + (size_t)(id_ >> 4) * 2304 + x_ * TOKW + (id_ & 15) * 8); } \
        pfT = gld<v4u>(TB + (unit_ * 2 + dir) * 4096 + tid * 8); pfTw = gld<v4u>(TBW + (unit_ * 2 + dir) * 4096 + tid * 8); \
        if (w == 0) { pg0 = gld<float>(G2 + (unit_ * 2 + dir) * 128 + lane); pg1 = gld<float>(G2 + (unit_ * 2 + dir) * 128 + 64 + lane); } } while (0)
    DN_PREFETCH(dir ? NCHUNK - 1 : 0);
    v2u oprev[4]; size_t tprev = 0;
#pragma unroll
    for (int it = 0; it < 4; ++it) oprev[it] = (v2u){0u, 0u};
#define DN_STORE_PREV() do { _Pragma("unroll") for (int it_ = 0; it_ < 4; ++it_) { bf16* op_ = OD + (tprev + 16 * it_ + 4 * g) * TOKW + h * DNH + 16 * w + i; \
        gst<bf16>(op_, (bf16)(oprev[it_].x & 0xffffu)); gst<bf16>(op_ + TOKW, (bf16)(oprev[it_].x >> 16)); gst<bf16>(op_ + 2 * TOKW, (bf16)(oprev[it_].y & 0xffffu)); gst<bf16>(op_ + 3 * TOKW, (bf16)(oprev[it_].y >> 16)); } } while (0)
#pragma unroll 1
    for (int cc = 0; cc < NCHUNK; ++cc) {
        const int c = dir ? (NCHUNK - 1 - cc) : cc; const size_t t0 = (size_t)b * SEQ + c * CH;
        LDS_BARRIER();
#pragma unroll
        for (int r2 = 0; r2 < 2; ++r2) { const int id = tid + 512 * r2, row = id >> 4, ch = id & 15;
            *(LAS v4u*)(Ql + row * DQ_S + ch * 16) = pf[0][r2]; *(LAS v4u*)(Vl + row * DV_S + ch * 16) = pf[2][r2];
            LAS unsigned char* kd = Kl + row * DK_S + (32 * (ch >> 2) + 4 * (ch & 3)) * 2;
            *(LAS v2u*)kd = (v2u){pf[1][r2].x, pf[1][r2].y}; *(LAS v2u*)(kd + 32) = (v2u){pf[1][r2].z, pf[1][r2].w}; }
        {   const int trow = tid >> 3, c0 = 8 * (tid & 7), o0 = trow * DT_S + ((c0 & 32) + pperm(c0 & 31)) * 2, o1 = trow * DT_S + ((c0 & 32) + pperm((c0 & 31) + 4)) * 2;
            *(LAS v2u*)(Tl + o0) = (v2u){pfT.x, pfT.y}; *(LAS v2u*)(Tl + o1) = (v2u){pfT.z, pfT.w}; *(LAS v2u*)(Twl + o0) = (v2u){pfTw.x, pfTw.y}; *(LAS v2u*)(Twl + o1) = (v2u){pfTw.z, pfTw.w}; }
        if (w == 0) { const float cs = pg0, beta = pg1, glast = __shfl(cs, dir ? 0 : 63);
            Gl[lane] = cs; Gl[128 + lane] = __expf(cs); Gl[192 + lane] = __expf(glast - cs); if (lane == 0) Gl[320] = __expf(glast); (void)beta; }
        if (cc > 0) DN_STORE_PREV();
        if (cc + 1 < NCHUNK) DN_PREFETCH(dir ? (NCHUNK - 2 - cc) : (cc + 1));
        LDS_BARRIER();
        if (VAR & 1) {   bf16x8v kT[2];
#pragma unroll
            for (int ks = 0; ks < 2; ++ks) kT[ks] = frag_tr(Kl, DK_S, 32 * ks, 16 * w, i, g);
#pragma unroll
            for (int it = 0; it < 4; ++it) { f32x4 acc = (f32x4){0.f, 0.f, 0.f, 0.f};
#pragma unroll
                for (int ks = 0; ks < 2; ++ks) acc = __builtin_amdgcn_mfma_f32_16x16x32_bf16(kT[ks], frag_row(Twl, 16 * it + i, DT_S, 32 * ks, g), acc, 0, 0, 0);
                const int r0 = 16 * w + 4 * g, x0 = (r0 & ~31) + pperm(r0 & 31);
                v2u wv; wv.x = pk2(-acc[0], -acc[1]); wv.y = pk2(-acc[2], -acc[3]); *(LAS v2u*)(Wl + (16 * it + i) * DW_S + x0 * 2) = wv; }
#pragma unroll
            for (int tt = 0; tt < 2; ++tt) { const int id = 2 * w + tt, it = id >> 2, jt = id & 3; f32x4 acc = (f32x4){0.f, 0.f, 0.f, 0.f};
#pragma unroll
                for (int ks = 0; ks < 4; ++ks) { const bf16x8v a = frag_row(Kl, 16 * jt + i, DK_S, 32 * ks, g);
                    LAS unsigned char* qp = Ql + (16 * it + i) * DQ_S + (32 * ks + 16 * (g & 1) + 4 * (g >> 1)) * 2; const bf16x8v bb = mk_frag(*(LAS v2u*)qp, *(LAS v2u*)(qp + 16));
                    acc = __builtin_amdgcn_mfma_f32_16x16x32_bf16(a, bb, acc, 0, 0, 0); }
                const int pi = 16 * it + i; const float gci = Gl[pi]; float v[4];
#pragma unroll
                for (int r = 0; r < 4; ++r) { const int pj = 16 * jt + 4 * g + r; const bool ok = dir ? (pj >= pi) : (pj <= pi); v[r] = ok ? acc[r] * __expf(gci - Gl[pj]) : 0.f; }
                v2u wv; wv.x = pk2(v[0], v[1]); wv.y = pk2(v[2], v[3]); { const int j0 = 16 * jt + 4 * g; *(LAS v2u*)(Il + pi * DI_S + ((j0 & ~31) + pperm(j0 & 31)) * 2) = wv; } }
        }
        LDS_BARRIER();
        if (VAR & 2) {   bf16x8v Sb[4];
#pragma unroll
            for (int ks = 0; ks < 4; ++ks) Sb[ks] = frag_acc(Sacc[2 * ks], Sacc[2 * ks + 1]);
            f32x4 vacc[4], oacc[4];
            {   bf16x8v vT[2];
#pragma unroll
                for (int ks = 0; ks < 2; ++ks) vT[ks] = frag_tr(Vl, DV_S, 32 * ks, 16 * w, i, g);
#pragma unroll
                for (int it = 0; it < 4; ++it) { f32x4 acc = (f32x4){0.f, 0.f, 0.f, 0.f};
#pragma unroll
                    for (int ks = 0; ks < 2; ++ks) acc = __builtin_amdgcn_mfma_f32_16x16x32_bf16(frag_row(Tl, 16 * it + i, DT_S, 32 * ks, g), vT[ks], acc, 0, 0, 0);
#pragma unroll
                    for (int ks = 0; ks < 4; ++ks) acc = __builtin_amdgcn_mfma_f32_16x16x32_bf16(frag_row(Wl, 16 * it + i, DW_S, 32 * ks, g), Sb[ks], acc, 0, 0, 0);
                    vacc[it] = acc; }
            }
#pragma unroll
            for (int it = 0; it < 4; ++it) { f32x4 acc = (f32x4){0.f, 0.f, 0.f, 0.f};
#pragma unroll
                for (int ks = 0; ks < 4; ++ks) acc = __builtin_amdgcn_mfma_f32_16x16x32_bf16(frag_row(Ql, 16 * it + i, DQ_S, 32 * ks, g), Sb[ks], acc, 0, 0, 0);
                const f32x4 egv = *(const LAS f32x4*)(Gl + 128 + 16 * it + 4 * g); oacc[it] = acc * egv; }
            bf16x8v Vb[2], Vk[2];
#pragma unroll
            for (int js = 0; js < 2; ++js) { const f32x4 e0 = *(const LAS f32x4*)(Gl + 192 + 32 * js + 4 * g), e1 = *(const LAS f32x4*)(Gl + 192 + 32 * js + 16 + 4 * g);
                Vb[js] = frag_acc(vacc[2 * js], vacc[2 * js + 1]); Vk[js] = frag_acc(vacc[2 * js] * e0, vacc[2 * js + 1] * e1); }
#pragma unroll
            for (int it = 0; it < 4; ++it) {
#pragma unroll
                for (int js = 0; js < 2; ++js) oacc[it] = __builtin_amdgcn_mfma_f32_16x16x32_bf16(frag_row(Il, 16 * it + i, DI_S, 32 * js, g), Vb[js], oacc[it], 0, 0, 0);
                oprev[it].x = pk2(oacc[it][0], oacc[it][1]); oprev[it].y = pk2(oacc[it][2], oacc[it][3]); }
            tprev = t0;
            const float egl = Gl[320];
#pragma unroll
            for (int kt = 0; kt < 8; ++kt) { f32x4 acc = Sacc[kt] * egl;
#pragma unroll
                for (int js = 0; js < 2; ++js) acc = __builtin_amdgcn_mfma_f32_16x16x32_bf16(frag_tr(Kl, DK_S, 32 * js, 16 * kt, i, g), Vk[js], acc, 0, 0, 0);
                Sacc[kt] = acc; }
        }
    }
    DN_STORE_PREV();
#undef DN_PREFETCH
#undef DN_STORE_PREV
    LDS_BARRIER();
}
__device__ __forceinline__ void dn_gate(Frame& F) {
    const int gw = F.vcu * NWAVES + F.wave, NGW = F.G * NWAVES, lane = F.lane;
    bf16* MIX = WSP(F, bf16, WS_MIX); const float* O = WSP(F, const float, WS_Y); const float* onorm = ARG_IN(9);
    const float n0 = gld<float>(onorm + lane), n1 = gld<float>(onorm + 64 + lane);
    for (int t = gw; t < T; t += NGW) {
#pragma unroll
        for (int h = 0; h < NHEAD_D; ++h) {
#if defined(MK_NAIVE_DN)
            const float o0 = O[(size_t)t * TOKW + h * DNH + lane], o1 = O[(size_t)t * TOKW + h * DNH + 64 + lane];
#else
            const bf16* of = WSP(F, const bf16, WS_OF) + (size_t)t * TOKW + h * DNH + lane; const bf16* ob = WSP(F, const bf16, WS_OB) + (size_t)t * TOKW + h * DNH + lane;
            const float o0 = bf2f(gld<bf16>(of)) + bf2f(gld<bf16>(ob)), o1 = bf2f(gld<bf16>(of + 64)) + bf2f(gld<bf16>(ob + 64));
#endif
            const float r = 1.0f / sqrtf(wave_sum(o0 * o0 + o1 * o1) * (1.f / DNH) + EPS);
            bf16* zp = MIX + (size_t)t * D + h * DNH + lane;
            const float z0 = bf2f(gld<bf16>(zp)), z1 = bf2f(gld<bf16>(zp + 64));
            gst<bf16>(zp, (bf16)f2bf(o0 * r * n0 * silu(z0))); gst<bf16>(zp + 64, (bf16)f2bf(o1 * r * n1 * silu(z1)));
        }
    }
}
__device__ __forceinline__ void zero_f32(Frame& F, float* p, size_t n4) {
    const size_t gt = (size_t)F.vcu * (NWAVES * 64) + F.tid, NT = (size_t)F.G * (NWAVES * 64);
    for (size_t i = gt; i < n4; i += NT) ((f32x4*)p)[i] = (f32x4){0.f, 0.f, 0.f, 0.f};
}

struct Args { const float* in[19]; float* out; unsigned char* ws; int ph_lo, ph_hi; };
__global__ void __launch_bounds__(NWAVES * 64, 2) mk_fwd(Args args) {
    extern __shared__ __attribute__((aligned(16))) unsigned char lds[];
    Frame F;
    F.lds = (LAS unsigned char*)lds; F.ldsg = lds;
    F.MISC = (volatile LAS unsigned*)(F.lds + MISC_OFF);
    F.tid = threadIdx.x; F.lane = F.tid & 63; F.wave = __builtin_amdgcn_readfirstlane(F.tid >> 6);
    F.G = gridDim.x; { const int bx = blockIdx.x; F.vcu = (F.G % 8 == 0) ? (bx % 8) * (F.G / 8) + bx / 8 : bx; }
    F.ws = args.ws; F.out = args.out;
    F.ctl = (gu32*)(F.ws + WS_CTL);
    for (int u = F.tid; u < (LDS_BYTES - LDSCTL_OFF) / 4; u += NWAVES * 64) ((LAS unsigned*)(F.lds + LDSCTL_OFF))[u] = 0u;
    __syncthreads();
    XcdBarrier bar; bar.bar = (unsigned*)(F.ctl + CW_BAR); bar.x = 0; bar.st = nullptr;
    if (N_LAUNCHES == 1) bar = xcd_barrier_post((unsigned*)(F.ctl + CW_BAR), F.MISC + 8);
#define GRID_BAR() do { if (N_LAUNCHES == 1) xcd_barrier(bar); } while (0)
    Frame F0 = F;
#pragma unroll 1
    for (int pi = args.ph_lo; pi < args.ph_hi; ++pi) {
    { int tid = F0.tid, wave = F0.wave, vcu = F0.vcu, G = F0.G, bx = blockIdx.x; unsigned char* ws = F0.ws; float* out = F0.out;
      asm volatile("" : "+v"(tid), "+s"(wave), "+s"(vcu), "+s"(G), "+s"(ws), "+s"(out), "+s"(bx)); F.bx = bx;
      F.tid = tid; F.lane = tid & 63; F.wave = wave; F.vcu = vcu; F.G = G; F.ws = (unsigned char*)(GAS unsigned char*)ws; F.out = (float*)(GAS float*)out; }
    bf16* XN = WSP(F, bf16, WS_XN); bf16* MIX = WSP(F, bf16, WS_MIX); float* Y = WSP(F, float, WS_Y); bf16* BIG = WSP(F, bf16, WS_BIG);
    const int code = PROG[pi], ph = code & 15, arg = code >> 4;
    if (ph == 0) {
        transpose_w(F, ARG_IN(3), D, ATT_IN, WSP(F, bf16, WS_W_ATT_IN), ATT_IN, 0);
        transpose_w(F, ARG_IN(4), D, D, WSP(F, bf16, WS_W_ATT_OUT), D, 0);
        transpose_w(F, ARG_IN(5), D, DN_IN, WSP(F, bf16, WS_W_DN_IN), DN_IN_P, 1);
        transpose_w(F, ARG_IN(10), D, D, WSP(F, bf16, WS_W_DN_OUT), D, 0);
        for (int i = 0; i < 2; ++i) {
            transpose_w(F, ARG_IN(12) + (size_t)i * D * 512, D, 512, WSP(F, bf16, WS_W_MEMKV) + (size_t)i * 512 * D, 512, 0);
            transpose_w(F, ARG_IN(17) + (size_t)i * D * GU, D, GU, WSP(F, bf16, WS_W_GU) + (size_t)i * GU * D, GU, 2);
            transpose_w(F, ARG_IN(18) + (size_t)i * DFF * D, DFF, D, WSP(F, bf16, WS_W_DOWN) + (size_t)i * D * DFF, D, 0);
            rms_rows_bf16(F, ARG_IN(1), ARG_IN(11) + i * D, WSP(F, bf16, WS_MEMN) + (size_t)i * NB * MEML * D, NB * MEML);
        }
        rms_rows_bf16(F, ARG_IN(0), ARG_IN(13), XN, T);
    }
    else if (ph == 1 || ph == 8) {
        if (ph == 8) zero_f32(F, Y, (size_t)T * TOKW / 4);
        { const int N = ph == 1 ? ATT_IN : DN_IN_P;
          pg8::Gemm g{XN, WSP(F, bf16, ph == 1 ? WS_W_ATT_IN : WS_W_DN_IN), T, N, D}; pg8::StaticOrder S; S.init(T, N, F.G, F.bx);
          pg8::EpiRoute E{ph == 1 ? 0 : 1, BIG, ph == 1 ? ATT_IN : 3 * TOKW, MIX, D, WSP(F, float, WS_GATE)};
          pg8::gemm_phase<pg8::EpiRoute, pg8::StaticOrder, PG8_ALIGN, PG8_SP2>(F.lds + RING_OFF, g, S, E); }
        if (ph == 1) {
#pragma unroll 1
            for (int i = 0; i < 2; ++i) {
                pg8::Gemm g{WSP(F, bf16, WS_MEMN) + (size_t)i * NB * MEML * D, WSP(F, bf16, WS_W_MEMKV) + (size_t)i * 512 * D, NB * MEML, 512, D};
                pg8::StaticOrder S; S.init(NB * MEML, 512, F.G, (F.bx + 64 * (i + 1)) % F.G);
                pg8::EpiRoute E{0, WSP(F, bf16, WS_MEMKV) + (size_t)i * NB * MEML * 512, 512, nullptr, 0, nullptr};
                pg8::gemm_phase<pg8::EpiRoute, pg8::StaticOrder, PG8_ALIGN, PG8_SP2>(F.lds + RING_OFF, g, S, E);
            }
        }
    }
    else if (ph == 2) {
#if defined(MK_NAIVE_ATTN)
        attn_band_naive(F);
        attn_mem_naive(F, BIG + 3 * TOKW, ATT_IN, WSP(F, const bf16, WS_MEMKV), F.vcu, F.G);
#else
        attn_phase_fast(F, false, F.vcu, F.G);
#endif
    }
    else if (ph == 3) { lse_mix(F); }
    else if (ph == 4 || ph == 7) {
        const bf16* A = ph == 4 ? MIX : BIG; const int K = ph == 4 ? D : DFF;
        const bf16* W = ph == 4 ? WSP(F, bf16, arg ? WS_W_DN_OUT : WS_W_ATT_OUT) : WSP(F, bf16, WS_W_DOWN) + (size_t)arg * D * DFF;
        pg8::Gemm g{A, W, T, D, K}; pg8::StaticOrder S; S.init(T, D, F.G, F.bx); pg8::EpiF32 E{Y, D};
        pg8::gemm_phase<pg8::EpiF32, pg8::StaticOrder, PG8_ALIGN, PG8_SP2>(F.lds + RING_OFF, g, S, E);
    }
    else if (ph == 5) {
        const float* xold = arg == 0 ? ARG_IN(0) : F.out;
        const float* gpost = arg == 0 ? ARG_IN(14) : (arg == 1 ? ARG_IN(16) : (arg == 2 ? ARG_IN(14) + D : ARG_IN(16) + D));
        const float* gpre = arg == 0 ? ARG_IN(15) : (arg == 1 ? ARG_IN(13) + D : (arg == 2 ? ARG_IN(15) + D : nullptr));
        row_pass(F, xold, Y, gpost, F.out, gpre, XN);
    }
    else if (ph == 6) {
        pg8::Gemm g{XN, WSP(F, bf16, WS_W_GU) + (size_t)arg * GU * D, T, GU, D}; pg8::StaticOrder S; S.init(T, GU, F.G, F.bx); pg8::EpiSwiglu E{BIG, DFF};
        pg8::gemm_phase<pg8::EpiSwiglu, pg8::StaticOrder, PG8_ALIGN, PG8_SP2>(F.lds + RING_OFF, g, S, E);
    }
    else if (ph == 9) {
        const bool split = F.G >= 192;
#pragma unroll 1
#if defined(MK_NAIVE_DN)
        for (int c = F.vcu; c < 96; c += F.G) dn_naive(F, c);
#else
        for (int c = F.vcu; c < 96; c += F.G) { if (arg == 4) dn_scan<MK_SCAN_VAR>(F, c); else dn_scan<3>(F, c); }
#endif
#if defined(MK_NAIVE_ATTN)
        if (!split || F.vcu >= 96) attn_mem_naive(F, MIX + TOKW, D, WSP(F, const bf16, WS_MEMKV) + (size_t)NB * MEML * 512, split ? F.vcu - 96 : F.vcu, split ? F.G - 96 : F.G);
#else
        if (arg != 2 && arg != 4 && (!split || F.vcu >= 96)) attn_phase_fast(F, true, split ? F.vcu - 96 : F.vcu, split ? F.G - 96 : F.G);
#endif
    }
    else if (ph == 10) { dn_gate(F); }
    else if (ph == 12) {
#if !defined(MK_NAIVE_DN)
        dn_prep(F);
#endif
    }
    else if (ph == 11) {
#if !defined(MK_NAIVE_DN)
#pragma unroll 1
        for (int u = F.vcu; u < NB * NHEAD_D * NCHUNK / 4; u += F.G) dn_tsolve_group(F, u);
#endif
    }
    if (pi + 1 < args.ph_hi) GRID_BAR();
    }
}

extern "C" void kernel_launch(void* const* d_in, const int* in_sizes, int n_in, void* d_out, int out_size, void* d_ws, size_t ws_size, hipStream_t stream) {
    static int grid = 0;
    if (grid == 0) {
        if (n_in != 19 || in_sizes[0] != T * D || out_size != T * D || ws_size < WS_END) { fprintf(stderr, "kernel_launch: unexpected shapes (n_in %d, in0 %d, out %d, ws %zu)\n", n_in, n_in > 0 ? in_sizes[0] : -1, out_size, ws_size); grid = -1; return; }
        int dev = 0, cus = 0, per_cu = 0;
        if (hipGetDevice(&dev) != hipSuccess || hipDeviceGetAttribute(&cus, hipDeviceAttributeMultiprocessorCount, dev) != hipSuccess) { grid = -1; return; }
        if (hipFuncSetAttribute((const void*)mk_fwd, hipFuncAttributeMaxDynamicSharedMemorySize, LDS_BYTES) != hipSuccess) { fprintf(stderr, "kernel_launch: hipFuncSetAttribute failed\n"); grid = -1; return; }
        if (hipOccupancyMaxActiveBlocksPerMultiprocessor(&per_cu, (const void*)mk_fwd, NWAVES * 64, LDS_BYTES) != hipSuccess || per_cu < 1)
            fprintf(stderr, "kernel_launch: note: occupancy query reports %d workgroups per CU\n", per_cu);
        (void)hipGetLastError();
        grid = cus;
    }
    if (grid < 0) return;
    if (hipMemsetAsync((char*)d_ws + WS_CTL, 0, CTL_ZERO_BYTES, stream) != hipSuccess) { fprintf(stderr, "kernel_launch: hipMemsetAsync failed\n"); return; }
    Args a{};
    for (int i = 0; i < 19; ++i) a.in[i] = (const float*)d_in[i];
    a.out = (float*)d_out; a.ws = (unsigned char*)d_ws;
    for (int li = 0; li < N_LAUNCHES; ++li) {
        a.ph_lo = (N_LAUNCHES == 1) ? 0 : li; a.ph_hi = (N_LAUNCHES == 1) ? N_PHASES : li + 1;
        hipLaunchKernelGGL(mk_fwd, dim3(grid), dim3(NWAVES * 64), LDS_BYTES, stream, a);
        const hipError_t le = hipPeekAtLastError();
        if (le != hipSuccess) { fprintf(stderr, "kernel_launch: launch %d failed: %s\n", li, hipGetErrorName(le)); break; }
    }
}
```
